# Optimizing an MI355X kernel written in HIP

```python
import jax
import jax.numpy as jnp
from jax import lax
import numpy as np

D_MODEL = 1024
BATCH = 16
SEQ = 2048
DEPTH = 2

CONV_WIDTH = 512
CONV_GROUPS = 8
CONV_K = 3
MLA_HEADS = 8
MLA_Q_LORA = 256
MLA_KV_LORA = 128
MLA_NOPE = 64
MLA_ROPE = 32
MLA_V = 64
MLA_QK = MLA_NOPE + MLA_ROPE
ROPE_THETA = 10000.0
DIL_PATTERNS = ((128, 1), (512, 4), (2048, 16))
DIL_GROUPS = len(DIL_PATTERNS)
DIL_HEADS = 8
DIL_HEAD_DIM = 64
DIL_WIDTH = DIL_HEADS * DIL_HEAD_DIM
N_BRANCH = 3
Q_BLOCK = 128
EPS = 1e-6

SPLIT_SIZES = ((CONV_WIDTH,) * 4
               + (MLA_Q_LORA, MLA_KV_LORA, MLA_ROPE, MLA_HEADS * MLA_V)
               + (DIL_GROUPS * DIL_WIDTH,) * 3 + (DIL_WIDTH,)
               + (N_BRANCH * D_MODEL,))
SPLIT_POINTS = tuple(int(v) for v in np.cumsum(SPLIT_SIZES)[:-1])
N_IN = int(sum(SPLIT_SIZES))

kernel_name = 'hybrid_gatedconv_mla_dilated_layer'


def rmsnorm(x, g):
    xf = x.astype(jnp.float32)
    y = xf * lax.rsqrt(jnp.mean(xf * xf, axis=-1, keepdims=True) + EPS)
    return (y * g.astype(jnp.float32)).astype(x.dtype)


def rope_tables(S):
    inv = ROPE_THETA ** (-jnp.arange(0, MLA_ROPE, 2, dtype=jnp.float32) / MLA_ROPE)
    ang = jnp.arange(S, dtype=jnp.float32)[:, None] * inv[None, :]
    return jnp.cos(ang), jnp.sin(ang)


def apply_rope(t, cos, sin):
    tf = t.astype(jnp.float32)
    t1, t2 = jnp.split(tf, 2, axis=-1)
    c = cos[None, :, None, :]
    s = sin[None, :, None, :]
    return jnp.concatenate([t1 * c - t2 * s, t2 * c + t1 * s], axis=-1).astype(t.dtype)


def alibi_slopes():
    n = DIL_GROUPS * DIL_HEADS
    m = 2.0 ** (-8.0 * jnp.arange(1, n + 1, dtype=jnp.float32) / n)
    return m.reshape(DIL_GROUPS, DIL_HEADS)


def causal_block_attention(q, k, v, scale):
    B, H, S, Dk = q.shape
    Dv = v.shape[-1]
    nqb = S // Q_BLOCK
    qb = q.reshape(B, H, nqb, Q_BLOCK, Dk).transpose(2, 0, 1, 3, 4)
    kf = k.astype(jnp.float32)
    vf = v.astype(jnp.float32)
    kpos = jnp.arange(S)

    def one_block(args):
        qblk, i = args
        s = jnp.einsum('bhqc,bhkc->bhqk', qblk.astype(jnp.float32), kf) * scale
        qpos = i * Q_BLOCK + jnp.arange(Q_BLOCK)
        s = jnp.where(kpos[None, :] <= qpos[:, None], s, -jnp.inf)
        p = jax.nn.softmax(s, axis=-1)
        return jnp.einsum('bhqk,bhkc->bhqc', p, vf)

    o = lax.map(one_block, (qb, jnp.arange(nqb)))
    return o.transpose(1, 2, 0, 3, 4).reshape(B, H, S, Dv)


def dilated_group_attention(q, k, v, slopes, dilation, n_back):
    B, S, H, hd = q.shape
    L = S // dilation
    nb = -(-L // Q_BLOCK)
    Lp = nb * Q_BLOCK

    def to_sub(t):
        return t.reshape(B, L, dilation, H, hd).transpose(0, 2, 3, 1, 4)

    qs = jnp.pad(to_sub(q).astype(jnp.float32), ((0, 0), (0, 0), (0, 0), (0, Lp - L), (0, 0)))
    qs = qs.reshape(B, dilation, H, nb, Q_BLOCK, hd)

    def windows(t):
        tp = jnp.pad(to_sub(t).astype(jnp.float32), ((0, 0), (0, 0), (0, 0), (Q_BLOCK, Lp - L), (0, 0)))
        tb = tp.reshape(B, dilation, H, nb + 1, Q_BLOCK, hd)
        return jnp.concatenate([tb[:, :, :, :-1], tb[:, :, :, 1:]], axis=4)

    kw = windows(k)
    vw = windows(v)
    qq = jnp.arange(Q_BLOCK)[:, None]
    kk = jnp.arange(2 * Q_BLOCK)[None, :]
    j = Q_BLOCK + qq - kk
    key_idx = (jnp.arange(nb)[:, None, None] - 1) * Q_BLOCK + kk[None]
    valid = (j >= 0) & (j <= n_back) & (key_idx >= 0)
    dist = (dilation * j).astype(jnp.float32)
    bias = -slopes.reshape(1, 1, H, 1, 1, 1) * dist
    scale = DIL_HEAD_DIM ** -0.5
    s = jnp.einsum('bdhnqc,bdhnkc->bdhnqk', qs, kw) * scale + bias
    s = jnp.where(valid, s, -jnp.inf)
    lse = jax.nn.logsumexp(s, axis=-1)
    p = jnp.exp(s - lse[..., None])
    o = jnp.einsum('bdhnqk,bdhnkc->bdhnqc', p, vw)
    o = o.reshape(B, dilation, H, Lp, hd)[:, :, :, :L]
    lse = lse.reshape(B, dilation, H, Lp)[:, :, :, :L]
    o = o.transpose(0, 3, 1, 2, 4).reshape(B, S, H, hd)
    lse = lse.transpose(0, 3, 1, 2).reshape(B, S, H)
    return o, lse


def hybrid_layer(x, norm_g, w_in, b_gate, conv_w, conv_b, q_a_norm_g, w_uq, kv_a_norm_g, w_ukv,
                 mla_q_norm_g, mla_k_norm_g, dil_q_norm_g, dil_k_norm_g,
                 w_out_a, w_out_b, w_out_c, w_o, cos, sin, slopes):
    B, S, _ = x.shape
    h = rmsnorm(x, norm_g)
    proj = h @ w_in
    (a_b, a_c, a_x, a_z, c_q, c_kv, k_pe, b_z, dq, dk, dv, c_z, gate_pre) = jnp.split(proj, SPLIT_POINTS, axis=-1)

    u = a_c * a_x
    up = jnp.pad(u, ((0, 0), (CONV_K - 1, 0), (0, 0)))
    conv = conv_b
    for tap in range(CONV_K):
        conv = conv + up[:, tap:tap + S] * conv_w[tap]
    y_a = a_b * conv * jax.nn.silu(a_z)

    q = (rmsnorm(c_q, q_a_norm_g) @ w_uq).reshape(B, S, MLA_HEADS, MLA_QK)
    kv = (rmsnorm(c_kv, kv_a_norm_g) @ w_ukv).reshape(B, S, MLA_HEADS, MLA_NOPE + MLA_V)
    k_nope, v = jnp.split(kv, [MLA_NOPE], axis=-1)
    k = jnp.concatenate([k_nope, jnp.broadcast_to(k_pe[:, :, None, :], (B, S, MLA_HEADS, MLA_ROPE))], axis=-1)
    q = rmsnorm(q, mla_q_norm_g)
    k = rmsnorm(k, mla_k_norm_g)
    q = jnp.concatenate([q[..., :MLA_NOPE], apply_rope(q[..., MLA_NOPE:], cos, sin)], axis=-1)
    k = jnp.concatenate([k[..., :MLA_NOPE], apply_rope(k[..., MLA_NOPE:], cos, sin)], axis=-1)
    o_b = causal_block_attention(q.transpose(0, 2, 1, 3), k.transpose(0, 2, 1, 3), v.transpose(0, 2, 1, 3),
                                 MLA_QK ** -0.5)
    o_b = o_b.transpose(0, 2, 1, 3).reshape(B, S, MLA_HEADS * MLA_V).astype(x.dtype)
    y_b = o_b * jax.nn.silu(b_z)

    dq = rmsnorm(dq.reshape(B, S, DIL_GROUPS, DIL_HEADS, DIL_HEAD_DIM), dil_q_norm_g[:, None, :])
    dk = rmsnorm(dk.reshape(B, S, DIL_GROUPS, DIL_HEADS, DIL_HEAD_DIM), dil_k_norm_g[:, None, :])
    dv = dv.reshape(B, S, DIL_GROUPS, DIL_HEADS, DIL_HEAD_DIM)
    outs = []
    lses = []
    for gi, (window, dilation) in enumerate(DIL_PATTERNS):
        o_g, lse_g = dilated_group_attention(dq[:, :, gi], dk[:, :, gi], dv[:, :, gi], slopes[gi],
                                             dilation, window // dilation)
        outs.append(o_g)
        lses.append(lse_g)
    alpha = jax.nn.softmax(jnp.stack(lses, axis=0), axis=0)
    o_c = jnp.sum(alpha[..., None] * jnp.stack(outs, axis=0), axis=0)
    o_c = o_c.reshape(B, S, DIL_WIDTH).astype(x.dtype)
    y_c = o_c * jax.nn.silu(c_z)

    g_a, g_b, g_c = jnp.split(jax.nn.sigmoid(gate_pre + b_gate), N_BRANCH, axis=-1)
    merged = g_a * (y_a @ w_out_a) + g_b * (y_b @ w_out_b) + g_c * (y_c @ w_out_c)
    return x + merged @ w_o


def setup_inputs(seed: int = 0) -> dict:
    key = jax.random.key(seed)
    ks = jax.random.split(key, 18)
    f32 = jnp.float32

    def nrm(k, shape, scale):
        return jax.random.normal(k, shape, f32) * scale

    def gain(k, shape):
        return 1.0 + 0.02 * jax.random.normal(k, shape, f32)

    Ld = DEPTH
    return {
        'x': jax.random.normal(ks[0], (BATCH, SEQ, D_MODEL), f32),
        'norm_g': gain(ks[1], (Ld, D_MODEL)),
        'w_in': nrm(ks[2], (Ld, D_MODEL, N_IN), D_MODEL ** -0.5),
        'b_gate': nrm(ks[3], (Ld, N_BRANCH * D_MODEL), 0.1),
        'conv_w': nrm(ks[4], (Ld, CONV_K, CONV_WIDTH), CONV_K ** -0.5),
        'conv_b': nrm(ks[5], (Ld, CONV_WIDTH), 0.02),
        'q_a_norm_g': gain(ks[6], (Ld, MLA_Q_LORA)),
        'w_uq': nrm(ks[7], (Ld, MLA_Q_LORA, MLA_HEADS * MLA_QK), MLA_Q_LORA ** -0.5),
        'kv_a_norm_g': gain(ks[8], (Ld, MLA_KV_LORA)),
        'w_ukv': nrm(ks[9], (Ld, MLA_KV_LORA, MLA_HEADS * (MLA_NOPE + MLA_V)), MLA_KV_LORA ** -0.5),
        'mla_q_norm_g': gain(ks[10], (Ld, MLA_QK)),
        'mla_k_norm_g': gain(ks[11], (Ld, MLA_QK)),
        'dil_q_norm_g': gain(ks[12], (Ld, DIL_GROUPS, DIL_HEAD_DIM)),
        'dil_k_norm_g': gain(ks[13], (Ld, DIL_GROUPS, DIL_HEAD_DIM)),
        'w_out_a': nrm(ks[14], (Ld, CONV_WIDTH, D_MODEL), CONV_WIDTH ** -0.5),
        'w_out_b': nrm(ks[15], (Ld, MLA_HEADS * MLA_V, D_MODEL), (MLA_HEADS * MLA_V) ** -0.5),
        'w_out_c': nrm(ks[16], (Ld, DIL_WIDTH, D_MODEL), DIL_WIDTH ** -0.5),
        'w_o': nrm(ks[17], (Ld, D_MODEL, D_MODEL), D_MODEL ** -0.5),
    }


def reference(x, norm_g, w_in, b_gate, conv_w, conv_b, q_a_norm_g, w_uq, kv_a_norm_g, w_ukv,
              mla_q_norm_g, mla_k_norm_g, dil_q_norm_g, dil_k_norm_g, w_out_a, w_out_b, w_out_c, w_o):
    cos, sin = rope_tables(x.shape[1])
    slopes = alibi_slopes()
    for l in range(DEPTH):
        x = hybrid_layer(x, norm_g[l], w_in[l], b_gate[l], conv_w[l], conv_b[l], q_a_norm_g[l], w_uq[l],
                         kv_a_norm_g[l], w_ukv[l], mla_q_norm_g[l], mla_k_norm_g[l], dil_q_norm_g[l],
                         dil_k_norm_g[l], w_out_a[l], w_out_b[l], w_out_c[l], w_o[l], cos, sin, slopes)
    return x
```

```cpp
#include <hip/hip_runtime.h>
#include <hip/hip_cooperative_groups.h>
#include <cstdio>
#include <cstdint>
namespace cg = cooperative_groups;

#define LAS __attribute__((address_space(3)))
typedef unsigned short bf16_t;
typedef short bf16x8 __attribute__((ext_vector_type(8)));
typedef float f32x4 __attribute__((ext_vector_type(4)));
typedef float f32x16 __attribute__((ext_vector_type(16)));
typedef unsigned u32x4 __attribute__((ext_vector_type(4)));
typedef unsigned u32x2 __attribute__((ext_vector_type(2)));

constexpr int DM = 1024, NB = 16, SEQ = 2048, CB = 8, TC = CB * SEQ, NCH = NB / CB;
constexpr int LDP = 11264;
constexpr int C_AB = 0, C_AC = 512, C_AX = 1024, C_AZ = 1536, C_CQ = 2048, C_CKV = 2304, C_KPE = 2432, C_BZ = 2560,
              C_DQ = 3072, C_DK = 4608, C_DV = 6144, C_CZ = 7680, C_GATE = 8192;
constexpr int C_MB = C_DQ;
constexpr int C_MACC = C_DK;
constexpr float EPS = 1e-6f;
constexpr float LOG2E = 1.4426950408889634f;

constexpr size_t W_IN = 0, W_UQ = (size_t)LDP * 1024 * 2, W_UKV = W_UQ + 768 * 256 * 2, W_OA = W_UKV + 1024 * 128 * 2,
                 W_OB = W_OA + 1024 * 512 * 2, W_OC = W_OB + 1024 * 512 * 2, W_O = W_OC + 1024 * 512 * 2, W_LAYER = W_O + 1024 * 1024 * 2;
constexpr size_t OFF_ROPE = 2 * W_LAYER, OFF_LSE = OFF_ROPE + 2048 * 16 * 8, OFF_SS = OFF_LSE + (size_t)TC * 24 * 4, OFF_SSX = OFF_SS + (size_t)TC * 8 * 4, OFF_R = OFF_SSX + (size_t)TC * 16 * 4;
constexpr size_t OFF_QB = OFF_R, OFF_KB = OFF_QB + (size_t)TC * 768 * 2, OFF_VB = OFF_KB + (size_t)TC * 768 * 2;
constexpr size_t OFF_XB = OFF_R;
constexpr size_t OFF_PROJ = OFF_VB + (size_t)TC * 512 * 2, OFF_BAR = OFF_PROJ + (size_t)TC * LDP * 2, WS_END = OFF_BAR + 16384;
static_assert(OFF_R % 256 == 0 && WS_END <= 536870912ull, "ws map");

typedef float f32x2_t __attribute__((ext_vector_type(2))); typedef __bf16 bf16x2_t __attribute__((ext_vector_type(2)));
__device__ __forceinline__ unsigned cvt_pk_bf16(float lo, float hi) { f32x2_t v = {lo, hi}; bf16x2_t b = __builtin_convertvector(v, bf16x2_t); return __builtin_bit_cast(unsigned, b); }
__device__ __forceinline__ float bf_lo(unsigned w) { return __uint_as_float(w << 16); }
__device__ __forceinline__ float bf_hi(unsigned w) { return __uint_as_float(w & 0xffff0000u); }
__device__ __forceinline__ float wave_sum(float v) {
#pragma unroll
    for (int o = 1; o < 64; o <<= 1) v += __shfl_xor(v, o);
    return v;
}
__device__ __forceinline__ float silu_f(float z) { return z * __builtin_amdgcn_rcpf(1.f + __expf(-z)); }
__device__ __forceinline__ float sigm_f(float z) { return __builtin_amdgcn_rcpf(1.f + __expf(-z)); }

namespace pg8 {
constexpr int BM = 256, BK = 64, HALF = 128, HTB = HALF * BK * 2, STAGE_BYTES = 8 * HTB, NXCD = 8, WGM = 8;
__host__ __device__ __forceinline__ int lds_byte(int r, int c) { const int st = (r >> 4) * 2 + (c >> 5), rr = r & 15, cc = c & 31, ob = rr * 64 + cc * 2; return st * 1024 + (ob ^ (((ob >> 9) & 1) << 5)); }
__host__ __device__ __forceinline__ void stage_rc(int b, int& R, int& C) { const int st = b / 1024, sb = b % 1024, swz = sb ^ (((sb >> 9) & 1) << 5); R = (st >> 1) * 16 + swz / 64; C = (st & 1) * 32 + (swz % 64) / 2; }
__host__ __device__ __forceinline__ int perm32(int rho) { const int n = rho >> 4, i = rho & 15; return 8 * (i >> 2) + 4 * n + (i & 3); }
struct Unit { int pm, pn, br; };
struct Gemm { const bf16_t* A; const bf16_t* Bt; int M, N, K, lda, ldb; };
struct StaticOrder {
    int nM, nN, nwg, G, c;
    __device__ void init(int M, int N, int G_, int c_) { nM = M / BM; nN = N / BM; nwg = nM * nN; G = G_; c = c_; }
    __device__ bool next(int i, Unit& u) const {
        const long L = (long)i * G + c; if (L >= nwg) return false;
        int wgid = (int)L; { const int q = nwg / NXCD, r = nwg % NXCD, xcd = wgid % NXCD, off = wgid / NXCD; wgid = (xcd < r ? xcd * (q + 1) : r * (q + 1) + (xcd - r) * q) + off; }
        const int nig = WGM * nN, gid = wgid / nig, fm = gid * WGM, gsz = (nM - fm) < WGM ? (nM - fm) : WGM;
        u.pm = fm + ((wgid % nig) % gsz); u.pn = (wgid % nig) / gsz; u.br = 0; return true;
    }
    __device__ __forceinline__ size_t aoff(const Unit&) const { return 0; }
    __device__ __forceinline__ size_t boff(const Unit&) const { return 0; }
};
struct MergeOrder {
    StaticOrder base;
    __device__ bool next(int i, Unit& u) const { const int ti = i / 3; if (!base.next(ti, u)) return false; u.br = i - 3 * ti; return true; }
    __device__ __forceinline__ size_t aoff(const Unit& u) const { return (size_t)(u.br == 0 ? C_AB : (u.br == 1 ? C_BZ : C_CZ)) * 2; }
    __device__ __forceinline__ size_t boff(const Unit& u) const { return (size_t)u.br * (1024 * 512 * 2); }
};

template <class Epi, class Sched, bool ALIGN_EPI = true, bool SP2 = true>
__device__ __forceinline__ void gemm_phase(LAS unsigned char* lds, const Gemm g, const Sched& S, const Epi& E, const int tid) {
    const int wid = __builtin_amdgcn_readfirstlane(tid >> 6), lane = tid & 63, wr = wid >> 2, wc = wid & 3, fr = lane & 15, fq = lane >> 4;
    const int K = g.K, nt = K / BK;
    unsigned voffA[2], voffB[2];
#pragma unroll
    for (int i = 0; i < 2; ++i) { int R, C; stage_rc(tid * 16 + i * 8192, R, C); const int Rb = (R & ~31) + perm32(R & 31);
        voffA[i] = (unsigned)(R * g.lda + C) * 2u; voffB[i] = (unsigned)(Rb * g.ldb + C) * 2u; }
    const size_t kstep = (size_t)(BK * 2);
    const size_t hstepA = (size_t)HALF * g.lda * 2, hstepB = (size_t)HALF * g.ldb * 2;
    const size_t tstepA = 2 * hstepA, tstepB = 2 * hstepB;
    const unsigned ldsw = (unsigned)wid * 1024u;
    const int aoff = lds_byte(wr * 64 + fr, fq * 8), boff = lds_byte(wc * 32 + fr, fq * 8);
#define PG8_SA(b, h) (((b) * 2 + (h)) * HTB)
#define PG8_SB(b, h) ((4 + (b) * 2 + (h)) * HTB)
#define PG8_STAGE(bufoff, gbase, voff) do { _Pragma("unroll") for (int _i = 0; _i < 2; ++_i) \
        __builtin_amdgcn_global_load_lds((const unsigned*)((const char*)(gbase) + (voff)[_i]), (LAS unsigned*)(lds + (bufoff) + ldsw + _i * 8192), 16, 0, 0); } while (0)
#define PG8_LDA(dst, b, h) do { _Pragma("unroll") for (int m = 0; m < 4; ++m) _Pragma("unroll") for (int k = 0; k < 2; ++k) dst[m][k] = *(const LAS bf16x8*)(lds + PG8_SA(b, h) + aoff + m * 2048 + k * 1024); } while (0)
#define PG8_LDB(dst, b, h) do { _Pragma("unroll") for (int n = 0; n < 2; ++n) _Pragma("unroll") for (int k = 0; k < 2; ++k) dst[n][k] = *(const LAS bf16x8*)(lds + PG8_SB(b, h) + boff + n * 2048 + k * 1024); } while (0)
#define PG8_MMA(ai, bj, At, Bt) do { __builtin_amdgcn_s_setprio(1); _Pragma("unroll") for (int m = 0; m < 4; ++m) _Pragma("unroll") for (int n = 0; n < 2; ++n) _Pragma("unroll") for (int k = 0; k < 2; ++k) \
        acc[ai][bj][m][n] = __builtin_amdgcn_mfma_f32_16x16x32_bf16(Bt[n][k], At[m][k], acc[ai][bj][m][n], 0, 0, 0); __builtin_amdgcn_s_setprio(0); } while (0)
#define PG8_WAIT_V(n) asm volatile("s_waitcnt vmcnt(" #n ")" ::: "memory")
#define PG8_WAIT_L(n) asm volatile("s_waitcnt lgkmcnt(" #n ")" ::: "memory")
#define PG8_BAR __builtin_amdgcn_s_barrier()
#define PG8_SCHED __builtin_amdgcn_sched_barrier(0)
    Unit cur, nxt; int ui = 0;
    if (!S.next(0, cur)) return;
    f32x4 acc[2][2][4][2];
#pragma unroll
    for (int a = 0; a < 2; ++a)
#pragma unroll
        for (int b = 0; b < 2; ++b)
#pragma unroll
            for (int m = 0; m < 4; ++m)
#pragma unroll
                for (int n = 0; n < 2; ++n) acc[a][b][m][n] = (f32x4){0.f, 0.f, 0.f, 0.f};
    bf16x8 At[4][2], B0[2][2], B1[2][2];
    const char* cA = (const char*)g.A + (size_t)cur.pm * tstepA + S.aoff(cur); const char* cB = (const char*)g.Bt + (size_t)cur.pn * tstepB + S.boff(cur);
    static_assert(SP2, "only the SP2 loop is kept");
    PG8_STAGE(PG8_SB(0, 0), cB, voffB); PG8_STAGE(PG8_SB(0, 1), cB + hstepB, voffB); PG8_STAGE(PG8_SA(0, 0), cA, voffA); PG8_STAGE(PG8_SA(0, 1), cA + hstepA, voffA);
    if (wr == 1) PG8_BAR;
    PG8_WAIT_V(2); PG8_BAR;
    PG8_STAGE(PG8_SB(1, 0), cB + kstep, voffB); PG8_STAGE(PG8_SA(1, 0), cA + kstep, voffA); PG8_STAGE(PG8_SB(1, 1), cB + hstepB + kstep, voffB);
    PG8_WAIT_V(6); PG8_BAR;
    for (;;) {
        const bool has_next = S.next(ui + 1, nxt);
        const char* nA = has_next ? (const char*)g.A + (size_t)nxt.pm * tstepA + S.aoff(nxt) : cA; const char* nB = has_next ? (const char*)g.Bt + (size_t)nxt.pn * tstepB + S.boff(nxt) : cB;
#pragma nounroll
        for (int t = 0; t < nt; t += 2) {
            const bool last = (t == nt - 2);
            const char* a1 = cA + (size_t)(t + 1) * kstep;
            const char* a2 = last ? nA : cA + (size_t)(t + 2) * kstep; const char* b2 = last ? nB : cB + (size_t)(t + 2) * kstep;
            const char* a3 = a2 + kstep; const char* b3 = b2 + kstep;
            PG8_LDB(B0, 0, 0); PG8_LDB(B1, 0, 1); PG8_SCHED; PG8_LDA(At, 0, 0); PG8_STAGE(PG8_SA(1, 1), a1 + hstepA, voffA);
            PG8_WAIT_V(8); PG8_WAIT_L(0); PG8_BAR; PG8_MMA(0, 0, At, B0); PG8_MMA(0, 1, At, B1); PG8_BAR; PG8_SCHED;
            PG8_LDA(At, 0, 1); PG8_STAGE(PG8_SB(0, 0), b2, voffB); PG8_STAGE(PG8_SB(0, 1), b2 + hstepB, voffB); PG8_STAGE(PG8_SA(0, 0), a2, voffA);
            PG8_WAIT_V(8); PG8_WAIT_L(0); PG8_BAR; PG8_MMA(1, 0, At, B0); PG8_MMA(1, 1, At, B1); PG8_BAR; PG8_SCHED;
            PG8_LDB(B0, 1, 0); PG8_LDB(B1, 1, 1); PG8_SCHED; PG8_LDA(At, 1, 0); PG8_STAGE(PG8_SA(0, 1), a2 + hstepA, voffA);
            PG8_WAIT_V(8); PG8_WAIT_L(0); PG8_BAR; PG8_MMA(0, 0, At, B0); PG8_MMA(0, 1, At, B1); PG8_BAR; PG8_SCHED;
            PG8_LDA(At, 1, 1); PG8_STAGE(PG8_SB(1, 0), b3, voffB); PG8_STAGE(PG8_SB(1, 1), b3 + hstepB, voffB); PG8_STAGE(PG8_SA(1, 0), a3, voffA);
            PG8_WAIT_V(8); PG8_WAIT_L(0); PG8_BAR; PG8_MMA(1, 0, At, B0); PG8_MMA(1, 1, At, B1); PG8_BAR; PG8_SCHED;
        }
        if constexpr (ALIGN_EPI) { if (wr == 0) PG8_BAR; }
        E(acc, cur, wr, wc, fr, fq);
        if (!has_next) break;
#pragma unroll
        for (int a = 0; a < 2; ++a)
#pragma unroll
            for (int b = 0; b < 2; ++b)
#pragma unroll
                for (int m = 0; m < 4; ++m)
#pragma unroll
                    for (int n = 0; n < 2; ++n) acc[a][b][m][n] = (f32x4){0.f, 0.f, 0.f, 0.f};
        cur = nxt; cA = nA; cB = nB; ++ui;
        if constexpr (ALIGN_EPI) { if (wr == 1) PG8_BAR; }
    }
    PG8_WAIT_V(0);
    if constexpr (!ALIGN_EPI) { if (wr == 0) PG8_BAR; }
    PG8_BAR;
#undef PG8_SA
#undef PG8_SB
#undef PG8_STAGE
#undef PG8_LDA
#undef PG8_LDB
#undef PG8_MMA
#undef PG8_WAIT_V
#undef PG8_WAIT_L
#undef PG8_BAR
#undef PG8_SCHED
}

struct EpiPlain {
    bf16_t* O; int ldc;
    __device__ __forceinline__ void operator()(const f32x4 (&acc)[2][2][4][2], const Unit& u, int wr, int wc, int fr, int fq) const {
        const int row0 = u.pm * BM + wr * 64 + fr, col0 = u.pn * BM + wc * 32 + 8 * fq;
#pragma unroll
        for (int ai = 0; ai < 2; ++ai)
#pragma unroll
            for (int m = 0; m < 4; ++m) { bf16_t* rowp = O + (size_t)(row0 + ai * HALF + m * 16) * ldc + col0;
#pragma unroll
                for (int bj = 0; bj < 2; ++bj) { const f32x4 v0 = acc[ai][bj][m][0], v1 = acc[ai][bj][m][1]; u32x4 w;
                    w.x = cvt_pk_bf16(v0[0], v0[1]); w.y = cvt_pk_bf16(v0[2], v0[3]); w.z = cvt_pk_bf16(v1[0], v1[1]); w.w = cvt_pk_bf16(v1[2], v1[3]);
                    *(u32x4*)(rowp + bj * HALF) = w; } }
    }
};
struct EpiProj {
    bf16_t* O; const float* gq; const float* gk;
    float* ss; bool st;
    __device__ __forceinline__ void operator()(const f32x4 (&acc)[2][2][4][2], const Unit& u, int wr, int wc, int fr, int fq) const {
        const int row0 = u.pm * BM + wr * 64 + fr, col0 = u.pn * BM + wc * 64 + 8 * fq;
        if (u.pn < 8) {
            const int ch0 = 64 * u.pn + 16 * wc + 4 * fq;
#pragma unroll
            for (int ai = 0; ai < 2; ++ai)
#pragma unroll
                for (int m = 0; m < 4; ++m) { const int row = u.pm * BM + wr * 64 + fr + ai * HALF + m * 16;
                    const f32x4 ab = acc[ai][0][m][0], ac = acc[ai][0][m][1], ax = acc[ai][1][m][0], az = acc[ai][1][m][1];
                    f32x4 gz, uu = ac * ax;
#pragma unroll
                    for (int i = 0; i < 4; ++i) gz[i] = ab[i] * silu_f(az[i]);
                    bf16_t* rowp = O + (size_t)row * LDP + ch0;
                    if (st) { *(u32x2*)(rowp + C_AB) = (u32x2){cvt_pk_bf16(gz[0], gz[1]), cvt_pk_bf16(gz[2], gz[3])}; *(u32x2*)(rowp + C_AC) = (u32x2){cvt_pk_bf16(uu[0], uu[1]), cvt_pk_bf16(uu[2], uu[3])}; }
                    else asm volatile("" :: "v"(gz), "v"(uu)); }
            return;
        }
        const bool nrm = (u.pn >= 12 && u.pn < 24);
        const bool stat = (u.pn == 8) || (u.pn == 9 && wc < 3);
        f32x4 gv[2][2];
        if (nrm) { const bool isq = u.pn < 18; const int gi = ((u.pn - 12) % 6) >> 1; const float* gp = (isq ? gq : gk) + gi * 64 + 8 * fq; const float post = isq ? 0.125f * LOG2E : 1.f;
#pragma unroll
            for (int bj = 0; bj < 2; ++bj)
#pragma unroll
                for (int n = 0; n < 2; ++n) gv[bj][n] = *(const f32x4*)(gp + bj * 32 + n * 4) * post;
        } else {
#pragma unroll
            for (int bj = 0; bj < 2; ++bj)
#pragma unroll
                for (int n = 0; n < 2; ++n) gv[bj][n] = (f32x4){1.f, 1.f, 1.f, 1.f};
        }
#pragma unroll
        for (int ai = 0; ai < 2; ++ai)
#pragma unroll
            for (int m = 0; m < 4; ++m) {
                const int row = row0 + ai * HALF + m * 16;
                f32x4 v[2][2];
#pragma unroll
                for (int bj = 0; bj < 2; ++bj)
#pragma unroll
                    for (int n = 0; n < 2; ++n) v[bj][n] = acc[ai][bj][m][n];
                float r = 1.f;
                if (nrm || stat) { float ss_ = 0.f;
#pragma unroll
                    for (int bj = 0; bj < 2; ++bj)
#pragma unroll
                        for (int n = 0; n < 2; ++n) { const f32x4 x = v[bj][n]; ss_ += (x[0] * x[0] + x[1] * x[1]) + (x[2] * x[2] + x[3] * x[3]); }
                    ss_ += __shfl_xor(ss_, 16); ss_ += __shfl_xor(ss_, 32);
                    if (nrm) r = rsqrtf(ss_ * (1.f / 64.f) + EPS);
                    else if (fq == 0) ss[(size_t)row * 8 + (u.pn == 8 ? wc : 4 + wc)] = ss_; }
                bf16_t* rowp = O + (size_t)row * LDP + col0;
#pragma unroll
                for (int bj = 0; bj < 2; ++bj) { const f32x4 v0 = v[bj][0] * r * gv[bj][0], v1 = v[bj][1] * r * gv[bj][1]; u32x4 w;
                    w.x = cvt_pk_bf16(v0[0], v0[1]); w.y = cvt_pk_bf16(v0[2], v0[3]); w.z = cvt_pk_bf16(v1[0], v1[1]); w.w = cvt_pk_bf16(v1[2], v1[3]);
                    if (st) *(u32x4*)(rowp + bj * 32) = w; else asm volatile("" :: "v"(w)); } }
    }
};
struct EpiKV {
    bf16_t* KBo; bf16_t* VBo; const bf16_t* proj; const float* ss; const float* gk; const float* rope;
    __device__ __forceinline__ void operator()(const f32x4 (&acc)[2][2][4][2], const Unit& u, int wr, int wc, int fr, int fq) const {
        const int row0 = u.pm * BM + wr * 64 + fr; const int wu = 4 * u.pn + wc;
        if (wu < 8) {
            f32x4 gv[2][2];
#pragma unroll
            for (int bj = 0; bj < 2; ++bj)
#pragma unroll
                for (int n = 0; n < 2; ++n) gv[bj][n] = *(const f32x4*)(gk + bj * 32 + 8 * fq + n * 4);
            const f32x4 g1 = *(const f32x4*)(gk + 64 + 4 * fq), g2 = *(const f32x4*)(gk + 80 + 4 * fq);
#pragma unroll
            for (int ai = 0; ai < 2; ++ai) {
                f32x4 s4h[4];
#pragma unroll
                for (int m = 0; m < 4; ++m) s4h[m] = *(const f32x4*)(ss + (size_t)(row0 + ai * HALF + m * 16) * 8 + 4);
                __builtin_amdgcn_sched_barrier(0);
#pragma unroll
                for (int m = 0; m < 4; ++m) {
                    const int row = row0 + ai * HALF + m * 16;
                    const f32x4 s4 = s4h[m];
                    const float rkv = rsqrtf((s4.x + s4.y) * (1.f / 128.f) + EPS);
                    f32x4 v[2][2]; float q = 0.f;
#pragma unroll
                    for (int bj = 0; bj < 2; ++bj)
#pragma unroll
                        for (int n = 0; n < 2; ++n) { v[bj][n] = acc[ai][bj][m][n] * rkv; const f32x4 x = v[bj][n]; q += (x[0] * x[0] + x[1] * x[1]) + (x[2] * x[2] + x[3] * x[3]); }
                    q += __shfl_xor(q, 16); q += __shfl_xor(q, 32);
                    const float rk = rsqrtf((q + s4.z) * (1.f / 96.f) + EPS);
                    bf16_t* kr = KBo + (size_t)row * 768 + 96 * wu;
#pragma unroll
                    for (int bj = 0; bj < 2; ++bj) { const f32x4 v0 = v[bj][0] * rk * gv[bj][0], v1 = v[bj][1] * rk * gv[bj][1]; u32x4 w;
                        w.x = cvt_pk_bf16(v0[0], v0[1]); w.y = cvt_pk_bf16(v0[2], v0[3]); w.z = cvt_pk_bf16(v1[0], v1[1]); w.w = cvt_pk_bf16(v1[2], v1[3]);
                        *(u32x4*)(kr + bj * 32 + 8 * fq) = w; }
                    const bf16_t* pe = proj + (size_t)row * LDP + C_KPE;
                    const u32x2 a = *(const u32x2*)(pe + 4 * fq), b = *(const u32x2*)(pe + 16 + 4 * fq);
                    const int pos = row & (SEQ - 1);
                    const f32x4 cs0 = *(const f32x4*)(rope + (size_t)(pos * 16 + 4 * fq) * 2), cs1 = *(const f32x4*)(rope + (size_t)(pos * 16 + 4 * fq) * 2 + 4);
                    const f32x4 t1 = (f32x4){bf_lo(a.x), bf_hi(a.x), bf_lo(a.y), bf_hi(a.y)} * g1 * rk, t2 = (f32x4){bf_lo(b.x), bf_hi(b.x), bf_lo(b.y), bf_hi(b.y)} * g2 * rk;
                    const f32x4 cc = (f32x4){cs0.x, cs0.z, cs1.x, cs1.z}, sn = (f32x4){cs0.y, cs0.w, cs1.y, cs1.w};
                    const f32x4 o1 = t1 * cc - t2 * sn, o2 = t2 * cc + t1 * sn;
                    *(u32x2*)(kr + 64 + 4 * fq) = (u32x2){cvt_pk_bf16(o1[0], o1[1]), cvt_pk_bf16(o1[2], o1[3])};
                    *(u32x2*)(kr + 80 + 4 * fq) = (u32x2){cvt_pk_bf16(o2[0], o2[1]), cvt_pk_bf16(o2[2], o2[3])};
                }
            }
        } else {
            typedef float f32x2v __attribute__((ext_vector_type(2)));
            f32x2v s2v[2][4];
#pragma unroll
            for (int ai = 0; ai < 2; ++ai)
#pragma unroll
                for (int m = 0; m < 4; ++m) s2v[ai][m] = *(const f32x2v*)(ss + (size_t)(row0 + ai * HALF + m * 16) * 8 + 4);
            __builtin_amdgcn_sched_barrier(0);
#pragma unroll
            for (int ai = 0; ai < 2; ++ai)
#pragma unroll
                for (int m = 0; m < 4; ++m) {
                    const int row = row0 + ai * HALF + m * 16;
                    const float rkv = rsqrtf((s2v[ai][m].x + s2v[ai][m].y) * (1.f / 128.f) + EPS);
                    bf16_t* vr = VBo + (size_t)row * 512 + 64 * (wu - 8);
#pragma unroll
                    for (int bj = 0; bj < 2; ++bj) { const f32x4 v0 = acc[ai][bj][m][0] * rkv, v1 = acc[ai][bj][m][1] * rkv; u32x4 w;
                        w.x = cvt_pk_bf16(v0[0], v0[1]); w.y = cvt_pk_bf16(v0[2], v0[3]); w.z = cvt_pk_bf16(v1[0], v1[1]); w.w = cvt_pk_bf16(v1[2], v1[3]);
                        *(u32x4*)(vr + bj * 32 + 8 * fq) = w; } }
        }
    }
};
struct EpiMerge {
    const bf16_t* proj; const float* bgate;
    __device__ __forceinline__ void operator()(const f32x4 (&acc)[2][2][4][2], const Unit& u, int wr, int wc, int fr, int fq) const {
        const int row0 = u.pm * BM + wr * 64 + fr, col0 = u.pn * BM + wc * 32 + 8 * fq; const int BR = u.br;
        f32x4 bg[2][2];
#pragma unroll
        for (int bj = 0; bj < 2; ++bj)
#pragma unroll
            for (int n = 0; n < 2; ++n) bg[bj][n] = *(const f32x4*)(bgate + BR * 1024 + col0 + bj * HALF + n * 4);
        const bool first = BR == 0, last = BR == 2;
        const int dcol = last ? C_MB : C_MACC;
        u32x4 gS[2][2], pS[2][2];
#define MG_LOAD(R, SET) do { const size_t rb_ = (size_t)(row0 + ((R) >> 2) * HALF + ((R) & 3) * 16) * LDP; \
            _Pragma("unroll") for (int bj_ = 0; bj_ < 2; ++bj_) { const int c_ = col0 + bj_ * HALF; \
                gS[SET][bj_] = *(const u32x4*)(proj + rb_ + C_GATE + BR * 1024 + c_); pS[SET][bj_] = *(const u32x4*)(proj + rb_ + C_MACC + c_); } } while (0)
        MG_LOAD(0, 0);
#pragma unroll
        for (int r = 0; r < 8; ++r) {
            const int ai = r >> 2, m = r & 3;
            if (r + 1 < 8) { if ((r & 1) == 0) MG_LOAD(r + 1, 1); else MG_LOAD(r + 1, 0); }
            __builtin_amdgcn_sched_barrier(0);
#pragma unroll
            for (int bj = 0; bj < 2; ++bj) { const size_t rb = (size_t)(row0 + ai * HALF + m * 16) * LDP; const int c = col0 + bj * HALF;
                const u32x4 g = gS[r & 1][bj], p = pS[r & 1][bj];
                f32x4 g0 = (f32x4){bf_lo(g.x), bf_hi(g.x), bf_lo(g.y), bf_hi(g.y)} + bg[bj][0], g1 = (f32x4){bf_lo(g.z), bf_hi(g.z), bf_lo(g.w), bf_hi(g.w)} + bg[bj][1];
#pragma unroll
                for (int i = 0; i < 4; ++i) { g0[i] = sigm_f(g0[i]); g1[i] = sigm_f(g1[i]); }
                f32x4 v0 = acc[ai][bj][m][0] * g0, v1 = acc[ai][bj][m][1] * g1;
                const f32x4 p0 = (f32x4){bf_lo(p.x), bf_hi(p.x), bf_lo(p.y), bf_hi(p.y)}, p1 = (f32x4){bf_lo(p.z), bf_hi(p.z), bf_lo(p.w), bf_hi(p.w)};
#pragma unroll
                for (int i = 0; i < 4; ++i) { v0[i] += first ? 0.f : p0[i]; v1[i] += first ? 0.f : p1[i]; }
                u32x4 w; w.x = cvt_pk_bf16(v0[0], v0[1]); w.y = cvt_pk_bf16(v0[2], v0[3]); w.z = cvt_pk_bf16(v1[0], v1[1]); w.w = cvt_pk_bf16(v1[2], v1[3]);
                *(u32x4*)(const_cast<bf16_t*>(proj) + rb + dcol + c) = w; }
            __builtin_amdgcn_sched_barrier(0);
        }
#undef MG_LOAD
    }
};
struct EpiRes {
    const float* xin; float* out; bf16_t* xb; float* ssx; bool st;
    __device__ __forceinline__ void operator()(const f32x4 (&acc)[2][2][4][2], const Unit& u, int wr, int wc, int fr, int fq) const {
        const int row0 = u.pm * BM + wr * 64 + fr, col0 = u.pn * BM + wc * 32 + 8 * fq;
#pragma unroll
        for (int aq = 0; aq < 4; ++aq) { const int ai = aq >> 1, m0 = (aq & 1) * 2;
            f32x4 xa[2][2], xc[2][2];
#pragma unroll
            for (int mm = 0; mm < 2; ++mm)
#pragma unroll
                for (int bj = 0; bj < 2; ++bj) { const size_t off = (size_t)(row0 + ai * HALF + (m0 + mm) * 16) * DM + col0 + bj * HALF;
                    xa[mm][bj] = *(const f32x4*)(xin + off); xc[mm][bj] = *(const f32x4*)(xin + off + 4); }
            __builtin_amdgcn_sched_barrier(0);
#pragma unroll
            for (int mm = 0; mm < 2; ++mm) { const int m = m0 + mm; const int row = row0 + ai * HALF + m * 16; const size_t off = (size_t)row * DM + col0; float q = 0.f;
#pragma unroll
                for (int bj = 0; bj < 2; ++bj) { const f32x4 a = xa[mm][bj] + acc[ai][bj][m][0], b = xc[mm][bj] + acc[ai][bj][m][1];
                    if (st) { *(f32x4*)(out + off + bj * HALF) = a; *(f32x4*)(out + off + bj * HALF + 4) = b; } else asm volatile("" :: "v"(a), "v"(b));
                    if (xb) { q += (a[0] * a[0] + a[1] * a[1]) + (a[2] * a[2] + a[3] * a[3]) + (b[0] * b[0] + b[1] * b[1]) + (b[2] * b[2] + b[3] * b[3]);
                        u32x4 w; w.x = cvt_pk_bf16(a[0], a[1]); w.y = cvt_pk_bf16(a[2], a[3]); w.z = cvt_pk_bf16(b[0], b[1]); w.w = cvt_pk_bf16(b[2], b[3]);
                        *(u32x4*)(xb + off + bj * HALF) = w; } }
                if (xb) { q += __shfl_xor(q, 16); q += __shfl_xor(q, 32); if (fq == 0) ssx[(size_t)row * 16 + 4 * u.pn + wc] = q; } }
            __builtin_amdgcn_sched_barrier(0);
        }
    }
};
}

struct HalfWork {
    const bf16_t *Q, *K, *V; bf16_t* O; float* lse;
    int rsq, rsk, rsv, rso, rsl;
    float slope2; int nback;
    const float *ssq, *gqn, *rope;
    int q0A, tloA, nA, q0B, tloB, nB;
};
template <int DK, bool MLA>
__device__ __forceinline__ void attn_core(LAS unsigned char* lds, const HalfWork& W, const int NS, const int tid, const bool do_store = true) {
    const int lane = tid & 63, r32 = lane & 31, hi = lane >> 5;
    const int wid = __builtin_amdgcn_readfirstlane(tid >> 6), hf = wid >> 2, w4 = wid & 3, ht = tid & 255;
    constexpr int KSTR = DK * 2 + 16, VSTR = 192, KBYTES = 64 * KSTR, BUFB = KBYTES + 64 * VSTR;
    constexpr int KP = DK / 8, NKI = KP + 1, NVI = 12, NKJ = (NKI + 3) / 4;
    LAS unsigned char* hb = lds + hf * (2 * BUFB);
    int koff[NKJ], voff[3];
#pragma unroll
    for (int j = 0; j < NKJ; ++j) { const int slot = 64 * (w4 + 4 * j) + lane, row = slot / (KP + 1), c = slot % (KP + 1); koff[j] = (row < 64 ? row : 0) * W.rsk + (c < KP ? c : 0) * 8; }
#pragma unroll
    for (int j = 0; j < 3; ++j) { const int slot = 64 * (w4 + 4 * j) + lane, row = slot / 12, c = slot % 12; voff[j] = row * W.rsv + (c < 8 ? c : 0) * 8; }
    bf16x8 qf[DK / 16];
    float m_run = -INFINITY, l_run = 0.f; f32x16 o0 = {}, o1 = {};
    const int ntot = W.nA + W.nB;
#define ATT_DMA(s, buf) do { const bool a_ = (s) < W.nA; const int t_ = a_ ? (W.tloA + (s)) : (W.tloB + (s) - W.nA); \
        const bf16_t* kp_ = W.K + (long)(64 * t_) * W.rsk; const bf16_t* vp_ = W.V + (long)(64 * t_) * W.rsv; LAS unsigned char* kb_ = hb + (buf) * BUFB; \
        _Pragma("unroll") for (int j_ = 0; j_ < NKJ; ++j_) { const int i_ = w4 + 4 * j_; if (i_ < NKI) __builtin_amdgcn_global_load_lds((const unsigned*)(kp_ + koff[j_]), (LAS unsigned*)(kb_ + i_ * 1024), 16, 0, 0); } \
        _Pragma("unroll") for (int j_ = 0; j_ < 3; ++j_) { const int i_ = w4 + 4 * j_; __builtin_amdgcn_global_load_lds((const unsigned*)(vp_ + voff[j_]), (LAS unsigned*)(kb_ + KBYTES + i_ * 1024), 16, 0, 0); } } while (0)
    if (ntot > 0) ATT_DMA(0, 0);
    asm volatile("s_waitcnt vmcnt(0)" ::: "memory");
    __syncthreads();
    for (int s = 0; s < NS; ++s) {
        if (s + 1 < ntot) ATT_DMA(s + 1, (s + 1) & 1);
        if (s < ntot) {
            const bool inA = s < W.nA; const int js = inA ? s : s - W.nA;
            const int q0 = inA ? W.q0A : W.q0B; const int t = (inA ? W.tloA : W.tloB) + js; const int nj = inA ? W.nA : W.nB;
            const int qrow = q0 + w4 * 32 + r32;
            if (js == 0) {
                const bf16_t* qp = W.Q + (long)qrow * W.rsq + hi * 8;
#pragma unroll
                for (int ds = 0; ds < DK / 16; ++ds) qf[ds] = *(const bf16x8*)(qp + ds * 16);
                m_run = -INFINITY; l_run = 0.f; o0 = (f32x16){}; o1 = (f32x16){};
                if (MLA) {
                    float qv[DK / 16][8]; float ssl = 0.f;
#pragma unroll
                    for (int ds = 0; ds < DK / 16; ++ds) { const u32x4 w = __builtin_bit_cast(u32x4, qf[ds]);
#pragma unroll
                        for (int e = 0; e < 4; ++e) { qv[ds][2 * e] = bf_lo(w[e]); qv[ds][2 * e + 1] = bf_hi(w[e]); ssl += qv[ds][2 * e] * qv[ds][2 * e] + qv[ds][2 * e + 1] * qv[ds][2 * e + 1]; } }
                    ssl += __shfl_xor(ssl, 32);
                    const f32x4 s4 = *(const f32x4*)(W.ssq + (size_t)qrow * 8);
                    const float rq = rsqrtf(((s4.x + s4.y) + (s4.z + s4.w)) * (1.f / 256.f) + EPS);
                    const float rn = rsqrtf(ssl * rq * rq * (1.f / 96.f) + EPS) * rq * (0.10206207261596575f * LOG2E);
#pragma unroll
                    for (int ds = 0; ds < DK / 16; ++ds) { const f32x4 ga = *(const f32x4*)(W.gqn + 16 * ds + 8 * hi), gb = *(const f32x4*)(W.gqn + 16 * ds + 8 * hi + 4);
#pragma unroll
                        for (int e = 0; e < 4; ++e) { qv[ds][e] *= rn * ga[e]; qv[ds][4 + e] *= rn * gb[e]; } }
                    const float* rp = W.rope + (size_t)(qrow * 16 + 8 * hi) * 2;
#pragma unroll
                    for (int e2 = 0; e2 < 4; ++e2) { const f32x4 cs = *(const f32x4*)(rp + 4 * e2);
                        { const float t1 = qv[DK / 16 - 2][2 * e2], t2 = qv[DK / 16 - 1][2 * e2]; qv[DK / 16 - 2][2 * e2] = t1 * cs.x - t2 * cs.y; qv[DK / 16 - 1][2 * e2] = t2 * cs.x + t1 * cs.y; }
                        { const float t1 = qv[DK / 16 - 2][2 * e2 + 1], t2 = qv[DK / 16 - 1][2 * e2 + 1]; qv[DK / 16 - 2][2 * e2 + 1] = t1 * cs.z - t2 * cs.w; qv[DK / 16 - 1][2 * e2 + 1] = t2 * cs.z + t1 * cs.w; } }
#pragma unroll
                    for (int ds = 0; ds < DK / 16; ++ds) { u32x4 w;
#pragma unroll
                        for (int e = 0; e < 4; ++e) w[e] = cvt_pk_bf16(qv[ds][2 * e], qv[ds][2 * e + 1]);
                        qf[ds] = __builtin_bit_cast(bf16x8, w); }
                }
            }
            const int qs = q0 + w4 * 32;
            const bool useful = (64 * t <= qs + 31) && (64 * t + 63 >= qs - W.nback);
            if (useful) {
                LAS const unsigned char* Kl = hb + (s & 1) * BUFB; LAS const unsigned char* Vl = Kl + KBYTES;
                f32x16 p0 = {}, p1 = {};
                bf16x8 kfa[DK / 16], kfb[DK / 16];
#pragma unroll
                for (int ds = 0; ds < DK / 16; ++ds) {
                    kfa[ds] = *(LAS const bf16x8*)(Kl + r32 * KSTR + ds * 32 + hi * 16);
                    kfb[ds] = *(LAS const bf16x8*)(Kl + (32 + r32) * KSTR + ds * 32 + hi * 16);
                }
                __builtin_amdgcn_sched_barrier(0);
#pragma unroll
                for (int ds = 0; ds < DK / 16; ++ds) {
                    p0 = __builtin_amdgcn_mfma_f32_32x32x16_bf16(kfa[ds], qf[ds], p0, 0, 0, 0);
                    p1 = __builtin_amdgcn_mfma_f32_32x32x16_bf16(kfb[ds], qf[ds], p1, 0, 0, 0);
                }
                u32x4 vfa[4], vfb[4];
                {
                    typedef short v4i16_t __attribute__((ext_vector_type(4)));
                    LAS const unsigned char* vb = Vl + (4 * hi + ((lane & 15) >> 2)) * VSTR + (16 * ((lane >> 4) & 1) + 4 * (lane & 3)) * 2;
#pragma unroll
                    for (int ks = 0; ks < 4; ++ks) {
                        const u32x2 a0 = __builtin_bit_cast(u32x2, __builtin_amdgcn_ds_read_tr16_b64_v4i16((LAS v4i16_t*)(vb + (16 * ks) * VSTR)));
                        const u32x2 a1 = __builtin_bit_cast(u32x2, __builtin_amdgcn_ds_read_tr16_b64_v4i16((LAS v4i16_t*)(vb + (16 * ks + 8) * VSTR)));
                        const u32x2 b0 = __builtin_bit_cast(u32x2, __builtin_amdgcn_ds_read_tr16_b64_v4i16((LAS v4i16_t*)(vb + (16 * ks) * VSTR + 64)));
                        const u32x2 b1 = __builtin_bit_cast(u32x2, __builtin_amdgcn_ds_read_tr16_b64_v4i16((LAS v4i16_t*)(vb + (16 * ks + 8) * VSTR + 64)));
                        vfa[ks] = (u32x4){a0.x, a0.y, a1.x, a1.y}; vfb[ks] = (u32x4){b0.x, b0.y, b1.x, b1.y};
                    }
                }
                __builtin_amdgcn_sched_barrier(0);
                const bool full = MLA && (64 * t + 63 <= qs);
                if (!full) {
                    const int kb = 64 * t + 4 * hi;
#pragma unroll
                    for (int r = 0; r < 16; ++r) { const int d0 = qrow - (kb + (r & 3) + 8 * (r >> 2)), d1 = d0 - 32;
                        p0[r] = (d0 >= 0 && d0 <= W.nback) ? (MLA ? p0[r] : p0[r] - W.slope2 * (float)d0) : -INFINITY;
                        p1[r] = (d1 >= 0 && d1 <= W.nback) ? (MLA ? p1[r] : p1[r] - W.slope2 * (float)d1) : -INFINITY; }
                }
                float mx = fmaxf(p0[0], p1[0]);
#pragma unroll
                for (int r = 1; r < 16; ++r) mx = fmaxf(mx, fmaxf(p0[r], p1[r]));
                mx = fmaxf(mx, __shfl_xor(mx, 32));
                const float mnew = fmaxf(m_run, mx);
                const float muse = (mnew == -INFINITY) ? 0.f : mnew;
                const float alpha = __builtin_amdgcn_exp2f(m_run - muse);
                m_run = mnew;
                float rs = 0.f;
#pragma unroll
                for (int r = 0; r < 16; ++r) { p0[r] = __builtin_amdgcn_exp2f(p0[r] - muse); p1[r] = __builtin_amdgcn_exp2f(p1[r] - muse); rs += p0[r] + p1[r]; }
                l_run = l_run * alpha + rs;
#pragma unroll
                for (int r = 0; r < 16; ++r) { o0[r] *= alpha; o1[r] *= alpha; }
                u32x4 pw[4];
#pragma unroll
                for (int e = 0; e < 4; ++e) { pw[0][e] = cvt_pk_bf16(p0[2 * e], p0[2 * e + 1]); pw[1][e] = cvt_pk_bf16(p0[8 + 2 * e], p0[9 + 2 * e]);
                    pw[2][e] = cvt_pk_bf16(p1[2 * e], p1[2 * e + 1]); pw[3][e] = cvt_pk_bf16(p1[8 + 2 * e], p1[9 + 2 * e]); }
#pragma unroll
                for (int ks = 0; ks < 4; ++ks) {
                    const bf16x8 pb = __builtin_bit_cast(bf16x8, pw[ks]);
                    o0 = __builtin_amdgcn_mfma_f32_32x32x16_bf16(__builtin_bit_cast(bf16x8, vfa[ks]), pb, o0, 0, 0, 0);
                    o1 = __builtin_amdgcn_mfma_f32_32x32x16_bf16(__builtin_bit_cast(bf16x8, vfb[ks]), pb, o1, 0, 0, 0);
                }
            }
            if (js == nj - 1 && do_store) {
                const float l = l_run + __shfl_xor(l_run, 32); const float inv = 1.f / l;
                bf16_t* op = W.O + (long)qrow * W.rso + 4 * hi;
#pragma unroll
                for (int j = 0; j < 4; ++j) {
                    float a0 = o0[4 * j] * inv, a1 = o0[4 * j + 1] * inv, a2 = o0[4 * j + 2] * inv, a3 = o0[4 * j + 3] * inv;
                    float b0 = o1[4 * j] * inv, b1 = o1[4 * j + 1] * inv, b2 = o1[4 * j + 2] * inv, b3 = o1[4 * j + 3] * inv;
                    if (MLA) { const u32x2 za = *(const u32x2*)(op + 8 * j), zb = *(const u32x2*)(op + 32 + 8 * j);
                        a0 *= silu_f(bf_lo(za.x)); a1 *= silu_f(bf_hi(za.x)); a2 *= silu_f(bf_lo(za.y)); a3 *= silu_f(bf_hi(za.y));
                        b0 *= silu_f(bf_lo(zb.x)); b1 *= silu_f(bf_hi(zb.x)); b2 *= silu_f(bf_lo(zb.y)); b3 *= silu_f(bf_hi(zb.y)); }
                    *(u32x2*)(op + 8 * j) = (u32x2){cvt_pk_bf16(a0, a1), cvt_pk_bf16(a2, a3)};
                    *(u32x2*)(op + 32 + 8 * j) = (u32x2){cvt_pk_bf16(b0, b1), cvt_pk_bf16(b2, b3)};
                }
                if (!MLA) { if (hi == 0) W.lse[(long)qrow * W.rsl] = m_run + __builtin_amdgcn_logf(l); }
            }
        }
        asm volatile("s_waitcnt vmcnt(0)" ::: "memory");
        __syncthreads();
    }
#undef ATT_DMA
}


#define XB_TMO      128
#define XB_XCNT(j)  (256  + 64 * (j))
#define XB_XSUB(j)  (1280 + 64 * (j))
#define XB_XGEN(j)  (2304 + 64 * (j))
#define XB_TOP      3328
#define XB_TOPGEN   3392
#define XCD_BAR_WORDS 3456
#define XB_SPIN_CAP (1u << 18)
__device__ __forceinline__ unsigned xb_ld(unsigned* p)              { return __hip_atomic_load(p, __ATOMIC_RELAXED, __HIP_MEMORY_SCOPE_AGENT); }
__device__ __forceinline__ unsigned xb_add(unsigned* p, unsigned v) { return __hip_atomic_fetch_add(p, v, __ATOMIC_RELAXED, __HIP_MEMORY_SCOPE_AGENT); }
__device__ __forceinline__ unsigned xb_xcc_id() { return (unsigned)__builtin_amdgcn_s_getreg((3 << 11) | 20) & 0xFu; }
#define XB_SPIN(cond, bar) do { unsigned _sp = 0; while (cond) { __builtin_amdgcn_s_sleep(1); \
    if ((++_sp & 255u) == 0u) { if (xb_ld(&(bar)[XB_TMO])) break; if (_sp > XB_SPIN_CAP) { atomicAdd(&(bar)[XB_TMO], 1u); break; } } } } while (0)
struct XcdBarrier { unsigned* bar; unsigned x; volatile LAS unsigned* st; };
__device__ __forceinline__ XcdBarrier xcd_barrier_post(unsigned* bar, volatile LAS unsigned* st) {
    XcdBarrier b; b.bar = bar; b.x = xb_xcc_id(); b.st = st;
    if (threadIdx.x == 0) (void)xb_add(&bar[XB_XCNT(b.x)], 1u);
    return b;
}
__device__ __forceinline__ void xcd_barrier_complete(unsigned* bar, unsigned x, unsigned& nloc, unsigned& nx) {
    const unsigned G = gridDim.x * gridDim.y * gridDim.z;
    unsigned sum, cnt, mine, sp = 0u;
    for (;;) {
        sum = 0u; cnt = 0u; mine = 0u;
#pragma unroll
        for (unsigned j = 0; j < 16; ++j) { const unsigned c = xb_ld(&bar[XB_XCNT(j)]); sum += c; cnt += (c > 0u) ? 1u : 0u; mine = (j == x) ? c : mine; }
        if (sum == G) break;
        __builtin_amdgcn_s_sleep(1);
        if ((++sp & 255u) == 0u) { if (xb_ld(&bar[XB_TMO])) break; if (sp > XB_SPIN_CAP) { atomicAdd(&bar[XB_TMO], 1u); break; } }
    }
    nloc = mine > 0u ? mine : 1u; nx = cnt > 0u ? cnt : 1u;
}
__device__ __forceinline__ void xcd_barrier(const XcdBarrier& b) {
    asm volatile("s_waitcnt vmcnt(0)" ::: "memory");
    __syncthreads();
    if (threadIdx.x == 0) {
        unsigned* bar = b.bar;
        __builtin_amdgcn_s_waitcnt(0);
        unsigned nloc = b.st[0], nx = b.st[1];
        if (nloc == 0u) { xcd_barrier_complete(bar, b.x, nloc, nx); b.st[0] = nloc; b.st[1] = nx; }
        const unsigned old = xb_add(&bar[XB_XSUB(b.x)], 1u);
        const unsigned gen = old / nloc;
        if (old + 1u == (gen + 1u) * nloc) {
            __builtin_amdgcn_fence(__ATOMIC_RELEASE, "agent");
            asm volatile("s_waitcnt vmcnt(0)" ::: "memory");
            const unsigned og = xb_add(&bar[XB_TOP], 1u);
            const unsigned tg = og / nx;
            if (og + 1u == (tg + 1u) * nx) xb_add(&bar[XB_TOPGEN], 1u);
            else XB_SPIN(xb_ld(&bar[XB_TOPGEN]) == tg, bar);
            __builtin_amdgcn_fence(__ATOMIC_ACQUIRE, "agent");
            xb_add(&bar[XB_XGEN(b.x)], 1u);
            asm volatile("s_waitcnt vmcnt(0)" ::: "memory");
        } else {
            XB_SPIN(xb_ld(&bar[XB_XGEN(b.x)]) == gen, bar);
            __builtin_amdgcn_fence(__ATOMIC_ACQUIRE, "agent");
            asm volatile("s_waitcnt vmcnt(0)" ::: "memory");
        }
    }
    __syncthreads();
}

#ifndef REP_SYNC
#define REP_SYNC 1
#endif
#ifndef REP_P1
#define REP_P1 1
#endif
#ifndef REP_MLA
#define REP_MLA 1
#endif
#ifndef REP_DIL
#define REP_DIL 1
#endif
#ifndef REP_P4
#define REP_P4 1
#endif
#ifndef REP_P2
#define REP_P2 1
#endif
#ifndef P1_NOSTORE
#define P1_NOSTORE 0
#endif
#ifndef REP_PRO
#define REP_PRO 1
#endif
#ifndef REP_E3
#define REP_E3 1
#endif
#ifndef REP_CONV
#define REP_CONV 1
#endif
#ifndef REP_P5
#define REP_P5 1
#endif
struct Params { const float* in[18]; float* out; unsigned char* ws; int ph_lo, ph_hi; };
enum { I_X = 0, I_NORMG, I_WIN, I_BGATE, I_CONVW, I_CONVB, I_QAG, I_WUQ, I_KVAG, I_WUKV, I_MQG, I_MKG, I_DQG, I_DKG, I_WOA, I_WOB, I_WOC, I_WO };

__device__ __forceinline__ void transpose_item(const float* W, int ldw, int K, int src_col0, bf16_t* WT, int dst_row0, int k0, LAS float* scr, int lane, const float* ks = nullptr, int mixa_kb = -1) {
    if (src_col0 >= 0) {
        float wv[32], sv[32];
#pragma unroll
        for (int i = 0; i < 32; ++i) { const int kk = 2 * i + (lane >> 5); const int e_ = lane & 31; const int col_ = mixa_kb < 0 ? src_col0 + e_ : 512 * (mixa_kb + ((e_ >> 2) & 1)) + src_col0 + 4 * (e_ >> 3) + (e_ & 3); wv[i] = W[(size_t)(k0 + kk) * ldw + col_]; sv[i] = ks ? ks[k0 + kk] : 1.f; }
        __builtin_amdgcn_sched_barrier(0);
#pragma unroll
        for (int i = 0; i < 32; ++i) { const int kk = 2 * i + (lane >> 5); scr[kk * 33 + (lane & 31)] = wv[i] * sv[i]; }
    } else {
#pragma unroll 8
        for (int i = 0; i < 32; ++i) { const int kk = 2 * i + (lane >> 5); scr[kk * 33 + (lane & 31)] = 0.f; }
    }
    asm volatile("s_waitcnt lgkmcnt(0)" ::: "memory");
    const int c = lane & 7;
#pragma unroll
    for (int j = 0; j < 4; ++j) { const int n = (lane >> 3) + 8 * j; const LAS float* s = scr + (8 * c) * 33 + n;
        u32x4 o; o.x = cvt_pk_bf16(s[0 * 33], s[1 * 33]); o.y = cvt_pk_bf16(s[2 * 33], s[3 * 33]); o.z = cvt_pk_bf16(s[4 * 33], s[5 * 33]); o.w = cvt_pk_bf16(s[6 * 33], s[7 * 33]);
        *(u32x4*)(WT + (size_t)(dst_row0 + n) * K + k0 + 8 * c) = o; }
    asm volatile("s_waitcnt lgkmcnt(0)" ::: "memory");
}

__device__ __forceinline__ void convert_rows(const float* x, bf16_t* xb, int gw, int NGW, int lane) {
    for (int m0 = gw; m0 < TC; m0 += 4 * NGW) {
        f32x4 v[4][4];
#pragma unroll
        for (int r = 0; r < 4; ++r) { const int m = m0 + r * NGW; const f32x4* xr = (const f32x4*)(x + (size_t)(m < TC ? m : gw) * DM) + lane;
#pragma unroll
            for (int j = 0; j < 4; ++j) v[r][j] = xr[64 * j]; }
        __builtin_amdgcn_sched_barrier(0);
#pragma unroll
        for (int r = 0; r < 4; ++r) { const int m = m0 + r * NGW; float s = 0.f;
#pragma unroll
            for (int j = 0; j < 4; ++j) s += (v[r][j].x * v[r][j].x + v[r][j].y * v[r][j].y) + (v[r][j].z * v[r][j].z + v[r][j].w * v[r][j].w);
            const float rr = rsqrtf(wave_sum(s) * (1.f / DM) + EPS);
            if (m < TC) { u32x2* o = (u32x2*)(xb + (size_t)m * DM) + lane;
#pragma unroll
                for (int j = 0; j < 4; ++j) o[64 * j] = (u32x2){cvt_pk_bf16(v[r][j].x * rr, v[r][j].y * rr), cvt_pk_bf16(v[r][j].z * rr, v[r][j].w * rr)}; } }
    }
}
__device__ __forceinline__ void rescale_rows(bf16_t* xb, const float* ssx, int gw, int NGW, int lane) {
    for (int m0 = gw; m0 < TC; m0 += 4 * NGW) {
        u32x4 w[4][2]; float t[4];
#pragma unroll
        for (int r = 0; r < 4; ++r) { const int m = m0 + r * NGW, mc = m < TC ? m : gw; t[r] = lane < 16 ? ssx[(size_t)mc * 16 + lane] : 0.f;
            const u32x4* o = (const u32x4*)(xb + (size_t)mc * DM) + lane; w[r][0] = o[0]; w[r][1] = o[64]; }
        __builtin_amdgcn_sched_barrier(0);
#pragma unroll
        for (int r = 0; r < 4; ++r) { const int m = m0 + r * NGW; const float rr = rsqrtf(wave_sum(t[r]) * (1.f / DM) + EPS);
            if (m < TC) { u32x4* o = (u32x4*)(xb + (size_t)m * DM) + lane;
#pragma unroll
                for (int j = 0; j < 2; ++j) { u32x4 y;
#pragma unroll
                    for (int e = 0; e < 4; ++e) y[e] = cvt_pk_bf16(bf_lo(w[r][j][e]) * rr, bf_hi(w[r][j][e]) * rr);
                    o[64 * j] = y; } } }
    }
}

__global__ void __launch_bounds__(512) mega(Params P) {
    extern __shared__ __attribute__((aligned(16))) unsigned char lds_raw[];
    LAS unsigned char* lds = (LAS unsigned char*)lds_raw;
    cg::grid_group grid = cg::this_grid();
    const int G = gridDim.x;
    unsigned char* ws = P.ws;
    float* ropet = (float*)(ws + OFF_ROPE);
    float* lsebuf = (float*)(ws + OFF_LSE);
    float* SS = (float*)(ws + OFF_SS); float* SSX = (float*)(ws + OFF_SSX);
    bf16_t* QB = (bf16_t*)(ws + OFF_QB); bf16_t* KB = (bf16_t*)(ws + OFF_KB); bf16_t* VB = (bf16_t*)(ws + OFF_VB);
    bf16_t* XB = (bf16_t*)(ws + OFF_XB); bf16_t* PROJ = (bf16_t*)(ws + OFF_PROJ);
    volatile LAS unsigned* bst = (volatile LAS unsigned*)(lds + 147456 - 16);
    if (threadIdx.x < 4) bst[threadIdx.x] = 0u;
    __syncthreads();
    const XcdBarrier xbar = xcd_barrier_post((unsigned*)(ws + OFF_BAR), bst);
    for (int ph = P.ph_lo; ph < P.ph_hi; ++ph) {
        if (ph > P.ph_lo) { for (int rs_ = 0; rs_ < REP_SYNC; ++rs_) { if (P.ph_hi > 100000) grid.sync(); else xcd_barrier(xbar); } }
        int tid = threadIdx.x; asm volatile("" : "+v"(tid));
        int bx = blockIdx.x; asm volatile("" : "+s"(bx));
        const int lane = tid & 63, wave = __builtin_amdgcn_readfirstlane(tid >> 6);
        const int gw = bx * 8 + wave, NGW = G * 8;
        if (ph == 0) {
            for (int rp_ = 0; rp_ < REP_PRO; ++rp_) {
            LAS float* scr = (LAS float*)(lds + wave * 16384);
            constexpr int IT_IN = (LDP / 32) * 16, IT_UQ = 24 * 4, IT_UKV = 32 * 2, IT_OUT = 32 * 8, IT_O = 32 * 16, IT_L = IT_IN + IT_UQ + IT_UKV + 3 * IT_OUT + IT_O;
            for (int it = gw; it < 2 * IT_L; it += NGW) {
                const int l = it / IT_L; int r = it % IT_L; unsigned char* wl = ws + (size_t)l * W_LAYER;
                if (r < IT_IN) { const int rg = r >> 4, kb = r & 15; const int p0 = 32 * rg, pn = p0 >> 8, within = p0 & 255, bj = within >> 7, wc = (within >> 5) & 3;
                    const int L = 256 * pn + 64 * wc + 32 * bj; const int src = L < 2464 ? L : (L < 2560 ? -1 : L - 96);
                    if (pn < 8) transpose_item(P.in[I_WIN] + (size_t)l * 1024 * 11168, 11168, 1024, 64 * pn + 16 * wc, (bf16_t*)(wl + W_IN), p0, 64 * kb, scr, lane, P.in[I_NORMG] + l * DM, 2 * bj);
                    else transpose_item(P.in[I_WIN] + (size_t)l * 1024 * 11168, 11168, 1024, src, (bf16_t*)(wl + W_IN), p0, 64 * kb, scr, lane, P.in[I_NORMG] + l * DM);
                    continue; }
                r -= IT_IN;
                if (r < IT_UQ) { transpose_item(P.in[I_WUQ] + (size_t)l * 256 * 768, 768, 256, 32 * (r >> 2), (bf16_t*)(wl + W_UQ), 32 * (r >> 2), 64 * (r & 3), scr, lane, P.in[I_QAG] + l * 256); continue; }
                r -= IT_UQ;
                if (r < IT_UKV) { const int rg = r >> 1, p0 = 32 * rg, pn = p0 >> 8, within = p0 & 255, bj = within >> 7, wc = (within >> 5) & 3, wu = 4 * pn + wc;
                    const int src = (wu < 8 ? 128 * wu : 128 * (wu - 8) + 64) + 32 * bj;
                    transpose_item(P.in[I_WUKV] + (size_t)l * 128 * 1024, 1024, 128, src, (bf16_t*)(wl + W_UKV), p0, 64 * (r & 1), scr, lane, P.in[I_KVAG] + l * 128); continue; }
                r -= IT_UKV;
                if (r < 3 * IT_OUT) { const int br = r / IT_OUT, q = r % IT_OUT; const float* src = P.in[I_WOA + br] + (size_t)l * 512 * 1024;
                    transpose_item(src, 1024, 512, 32 * (q >> 3), (bf16_t*)(wl + W_OA + (size_t)br * 1024 * 512 * 2), 32 * (q >> 3), 64 * (q & 7), scr, lane); continue; }
                r -= 3 * IT_OUT;
                transpose_item(P.in[I_WO] + (size_t)l * 1024 * 1024, 1024, 1024, 32 * (r >> 4), (bf16_t*)(wl + W_O), 32 * (r >> 4), 64 * (r & 15), scr, lane);
            }
            for (int i = bx * 512 + tid; i < 2048 * 16; i += G * 512) {
                const int pos = i >> 4, f = i & 15;
                const float inv = exp2f(-(float)f * (13.287712379549449f / 16.f));
                const float ang = (float)pos * inv;
                const double rev = (double)ang * 0.15915494309189535; const double fr = rev - rint(rev);
                const float a = (float)(fr * 6.283185307179586);
                ropet[2 * i] = cosf(a); ropet[2 * i + 1] = sinf(a);
            }
            convert_rows(P.in[I_X], XB, gw, NGW, lane);
            }
            continue;
        }
        const int id = ph - 1, kk13 = id % 11, chunk = id / 11, layer = kk13 >= 5 ? 1 : 0, k = layer == 0 ? kk13 : kk13 - 6;
        const size_t tok0 = (size_t)chunk * TC;
        const float* xin = (layer == 0 ? P.in[I_X] : P.out) + tok0 * DM;
        float* xout = P.out + tok0 * DM;
        unsigned char* wl = ws + (size_t)layer * W_LAYER;
        if (k < 0) {
            rescale_rows(XB, SSX, gw, NGW, lane);
        } else if (k == 0) {
            pg8::Gemm g{XB, (const bf16_t*)(wl + W_IN), TC, LDP, DM, DM, DM}; pg8::StaticOrder S; S.init(TC, LDP, G, bx);
            for (int rp_ = 0; rp_ < REP_P1; ++rp_) { pg8::EpiProj E{PROJ, P.in[I_DQG] + layer * 192, P.in[I_DKG] + layer * 192, SS, P1_NOSTORE ? rp_ == REP_P1 - 1 : true}; pg8::gemm_phase<pg8::EpiProj, pg8::StaticOrder>(lds, g, S, E, tid); asm volatile("" : "+v"(tid)); }
        } else if (k == 1) {
            for (int rp_ = 0; rp_ < REP_P2; ++rp_) {
            { int kk = 128; asm volatile("" : "+s"(kk)); pg8::Gemm g{PROJ + C_CKV, (const bf16_t*)(wl + W_UKV), TC, 1024, kk, LDP, 128}; pg8::StaticOrder S; S.init(TC, 1024, G, bx);
              pg8::EpiKV E{KB, VB, PROJ, SS, P.in[I_MKG] + layer * 96, ropet}; pg8::gemm_phase<pg8::EpiKV, pg8::StaticOrder>(lds, g, S, E, tid); }
            asm volatile("" : "+v"(tid)); asm volatile("" : "+s"(bx));
            { int kq = 256; asm volatile("" : "+s"(kq)); pg8::Gemm g{PROJ + C_CQ, (const bf16_t*)(wl + W_UQ), TC, 768, kq, LDP, 256}; pg8::StaticOrder S; S.init(TC, 768, G, G - 1 - bx);
              pg8::EpiPlain E{QB, 768}; pg8::gemm_phase<pg8::EpiPlain, pg8::StaticOrder>(lds, g, S, E, tid); }
            asm volatile("" : "+v"(tid)); }
            asm volatile("" : "+v"(tid)); asm volatile("" : "+s"(bx));
            const int hf = wave >> 2;
            for (int v = ((G & 7) == 0 ? (bx & 7) * (G >> 3) + (bx >> 3) : bx); v < 1536; v += G) {
                const int pp = v & 7, h = (v >> 3) & 7, gi = (v >> 6) % 3, b = v / 192;
                const int dil = gi == 0 ? 1 : (gi == 1 ? 4 : 16), nbc = 16 / dil;
                const int idx = 2 * pp + hf, r = idx / nbc, n = idx % nbc, n_other = (idx ^ 1) % nbc;
                const size_t row0 = (size_t)b * SEQ + r;
                HalfWork W;
                W.Q = PROJ + row0 * LDP + C_DQ + gi * 512 + 64 * h; W.K = PROJ + row0 * LDP + C_DK + gi * 512 + 64 * h; W.V = PROJ + row0 * LDP + C_DV + gi * 512 + 64 * h;
                W.O = const_cast<bf16_t*>(W.Q); W.lse = lsebuf + row0 * 24 + gi * 8 + h;
                W.rsq = W.rsk = W.rsv = W.rso = dil * LDP; W.rsl = dil * 24;
                const float slope = exp2f(-8.f * (float)(gi * 8 + h + 1) / 24.f);
                W.slope2 = slope * (float)dil * LOG2E; W.nback = 128;
                W.ssq = nullptr; W.gqn = nullptr; W.rope = nullptr;
                W.q0A = 128 * n; W.tloA = n > 0 ? 2 * n - 2 : 0; W.nA = 2 * n + 2 - W.tloA; W.q0B = 0; W.tloB = 0; W.nB = 0;
                const int n_oth = n_other > 0 ? 4 : 2;
                for (int rp_ = 0; rp_ < REP_DIL; ++rp_) attn_core<64, false>(lds, W, W.nA > n_oth ? W.nA : n_oth, tid, rp_ == REP_DIL - 1);
            }
            {
                const float* cw = P.in[I_CONVW] + layer * 3 * 512; const float* cb = P.in[I_CONVB] + layer * 512;
                for (int rp_ = 0; rp_ < REP_CONV; ++rp_)
                for (int it = bx * 512 + tid; it < (TC / 8) * 64; it += G * 512) {
                    const int cgp = it & 63, t0 = (it >> 6) * 8, c0 = 8 * cgp;
                    float w0[8], w1[8], w2[8], bb[8], u1[8], u2[8];
#pragma unroll
                    for (int e = 0; e < 8; ++e) { w0[e] = cw[c0 + e]; w1[e] = cw[512 + c0 + e]; w2[e] = cw[1024 + c0 + e]; bb[e] = cb[c0 + e]; u1[e] = 0.f; u2[e] = 0.f; }
                    if ((t0 & (SEQ - 1)) != 0) {
                        const u32x4 x1 = *(const u32x4*)(PROJ + (size_t)(t0 - 1) * LDP + C_AC + c0), x2 = *(const u32x4*)(PROJ + (size_t)(t0 - 2) * LDP + C_AC + c0);
#pragma unroll
                        for (int e = 0; e < 4; ++e) { u1[2 * e] = bf_lo(x1[e]); u1[2 * e + 1] = bf_hi(x1[e]); u2[2 * e] = bf_lo(x2[e]); u2[2 * e + 1] = bf_hi(x2[e]); }
                    }
                    u32x4 vg[8], vu[8];
#pragma unroll
                    for (int tt = 0; tt < 8; ++tt) { const bf16_t* rr = PROJ + (size_t)(t0 + tt) * LDP + c0; vg[tt] = *(const u32x4*)(rr + C_AB); vu[tt] = *(const u32x4*)(rr + C_AC); }
                    __builtin_amdgcn_sched_barrier(0);
#pragma unroll
                    for (int tt = 0; tt < 8; ++tt) {
                        bf16_t* rr = PROJ + (size_t)(t0 + tt) * LDP + c0; u32x4 y;
#pragma unroll
                        for (int e = 0; e < 4; ++e) {
                            const float ua = bf_lo(vu[tt][e]), ub = bf_hi(vu[tt][e]);
                            const float ca = bb[2 * e] + w0[2 * e] * u2[2 * e] + w1[2 * e] * u1[2 * e] + w2[2 * e] * ua;
                            const float cbv = bb[2 * e + 1] + w0[2 * e + 1] * u2[2 * e + 1] + w1[2 * e + 1] * u1[2 * e + 1] + w2[2 * e + 1] * ub;
                            u2[2 * e] = u1[2 * e]; u1[2 * e] = ua; u2[2 * e + 1] = u1[2 * e + 1]; u1[2 * e + 1] = ub;
                            y[e] = cvt_pk_bf16(bf_lo(vg[tt][e]) * ca, bf_hi(vg[tt][e]) * cbv); }
                        if (rp_ == REP_CONV - 1) *(u32x4*)(rr + C_AB) = y; else asm volatile("" :: "v"(y));
                    }
                }
            }
        } else if (k == 2) {
            const int hf = wave >> 2;
            for (int u = ((G & 7) == 0 ? (bx & 7) * (G >> 3) + (bx >> 3) : bx); u < 256; u += G) {
                const int b = u >> 5, hp = (u >> 3) & 3, p = u & 7, h = 2 * hp + hf;
                const int qbA = hf == 0 ? p : 15 - p, qbB = 15 - qbA;
                HalfWork W;
                W.Q = QB + (size_t)b * SEQ * 768 + 96 * h; W.K = KB + (size_t)b * SEQ * 768 + 96 * h; W.V = VB + (size_t)b * SEQ * 512 + 64 * h;
                W.O = PROJ + (size_t)b * SEQ * LDP + C_BZ + 64 * h; W.lse = nullptr;
                W.rsq = 768; W.rsk = 768; W.rsv = 512; W.rso = LDP; W.rsl = 0; W.slope2 = 0.f; W.nback = 1 << 28;
                W.ssq = SS + (size_t)b * SEQ * 8; W.gqn = P.in[I_MQG] + layer * 96; W.rope = ropet;
                W.q0A = 128 * qbA; W.tloA = 0; W.nA = 2 * qbA + 2; W.q0B = 128 * qbB; W.tloB = 0; W.nB = 2 * qbB + 2;
                for (int rp_ = 0; rp_ < REP_MLA; ++rp_) attn_core<96, true>(lds, W, 34, tid, rp_ == REP_MLA - 1);
            }
            for (int rp_ = 0; rp_ < REP_E3; ++rp_)
            for (int m0 = gw; m0 < TC; m0 += 4 * NGW) {
                const int h = lane >> 3, dc = lane & 7;
                u32x4 oa[4], ob[4], oc[4], zz[4]; float la[4], lb[4], lc[4];
#pragma unroll
                for (int r = 0; r < 4; ++r) { const int m = m0 + r * NGW, mc = m < TC ? m : gw; const bf16_t* row = PROJ + (size_t)mc * LDP; const float* ls = lsebuf + (size_t)mc * 24 + h;
                    la[r] = ls[0]; lb[r] = ls[8]; lc[r] = ls[16];
                    oa[r] = *(const u32x4*)(row + C_DQ + 64 * h + 8 * dc); ob[r] = *(const u32x4*)(row + C_DQ + 512 + 64 * h + 8 * dc); oc[r] = *(const u32x4*)(row + C_DQ + 1024 + 64 * h + 8 * dc);
                    zz[r] = *(const u32x4*)(row + C_CZ + 64 * h + 8 * dc); }
                __builtin_amdgcn_sched_barrier(0);
#pragma unroll
                for (int r = 0; r < 4; ++r) { const int m = m0 + r * NGW;
                    const float mx = fmaxf(la[r], fmaxf(lb[r], lc[r]));
                    float a0 = __builtin_amdgcn_exp2f(la[r] - mx), a1 = __builtin_amdgcn_exp2f(lb[r] - mx), a2 = __builtin_amdgcn_exp2f(lc[r] - mx); const float inv = __builtin_amdgcn_rcpf(a0 + a1 + a2); a0 *= inv; a1 *= inv; a2 *= inv;
                    u32x4 y;
#pragma unroll
                    for (int e = 0; e < 4; ++e) {
                        const float lo = (a0 * bf_lo(oa[r][e]) + a1 * bf_lo(ob[r][e]) + a2 * bf_lo(oc[r][e])) * silu_f(bf_lo(zz[r][e]));
                        const float hi = (a0 * bf_hi(oa[r][e]) + a1 * bf_hi(ob[r][e]) + a2 * bf_hi(oc[r][e])) * silu_f(bf_hi(zz[r][e]));
                        y[e] = cvt_pk_bf16(lo, hi); }
                    if (m < TC) { if (rp_ == REP_E3 - 1) *(u32x4*)(PROJ + (size_t)m * LDP + C_CZ + 64 * h + 8 * dc) = y; else asm volatile("" :: "v"(y)); } }
            }
        } else if (k == 3) {
            pg8::MergeOrder S; S.base.init(TC, DM, G, bx);
            for (int rp_ = 0; rp_ < REP_P4; ++rp_) {
            pg8::Gemm g{PROJ, (const bf16_t*)(wl + W_OA), TC, DM, 512, LDP, 512}; pg8::EpiMerge E{PROJ, P.in[I_BGATE] + layer * 3072};
            pg8::gemm_phase<pg8::EpiMerge, pg8::MergeOrder>(lds, g, S, E, tid); asm volatile("" : "+v"(tid)); }
        } else {
            pg8::Gemm g{PROJ + C_MB, (const bf16_t*)(wl + W_O), TC, DM, DM, LDP, DM}; pg8::StaticOrder S; S.init(TC, DM, G, bx);
            for (int rp_ = 0; rp_ < REP_P5; ++rp_) { pg8::EpiRes E{xin, xout, layer == 0 ? XB : nullptr, SSX, rp_ == REP_P5 - 1}; pg8::gemm_phase<pg8::EpiRes, pg8::StaticOrder>(lds, g, S, E, tid); asm volatile("" : "+v"(tid)); }
            if (layer == 1 && chunk + 1 < NCH) convert_rows(P.in[I_X] + (tok0 + TC) * DM, XB, gw, NGW, lane);
        }
    }
}

constexpr int N_PHASES = 1 + NCH * 11;
constexpr int LDS_BYTES = 147456;

extern "C" void kernel_launch(void* const* d_in, const int* in_sizes, int n_in, void* d_out, int out_size, void* d_ws, size_t ws_size, hipStream_t stream) {
    static int grid = 0;
    if (grid == 0) {
        int dev = 0, cus = 0, per_cu = 0;
        hipGetDevice(&dev);
        hipDeviceGetAttribute(&cus, hipDeviceAttributeMultiprocessorCount, dev);
        hipFuncSetAttribute((const void*)mega, hipFuncAttributeMaxDynamicSharedMemorySize, LDS_BYTES);
        hipOccupancyMaxActiveBlocksPerMultiprocessor(&per_cu, (const void*)mega, 512, LDS_BYTES);
        (void)hipGetLastError();
        grid = cus;
        if (n_in != 18 || ws_size < WS_END || out_size != NB * SEQ * DM) { fprintf(stderr, "kernel_launch: unexpected shapes / workspace\n"); grid = -1; }
    }
    if (grid < 0) return;
    (void)hipMemsetAsync((unsigned char*)d_ws + OFF_BAR, 0, 16384, stream);
    Params p{};
    for (int i = 0; i < 18; ++i) p.in[i] = (const float*)d_in[i];
    p.out = (float*)d_out; p.ws = (unsigned char*)d_ws; p.ph_lo = 0; p.ph_hi = N_PHASES;
    void* args[] = {&p};
    hipError_t e = hipLaunchCooperativeKernel((const void*)mega, dim3(grid), dim3(512), args, LDS_BYTES, stream);
    if (e != hipSuccess) fprintf(stderr, "cooperative launch failed: %s\n", hipGetErrorString(e));
}
```

```cpp
#include <hip/hip_runtime.h>
#include <hip/hip_cooperative_groups.h>
#include <cstdio>
#include <cstdint>
namespace cg = cooperative_groups;

#define LAS __attribute__((address_space(3)))
typedef unsigned short bf16_t;
typedef short bf16x8 __attribute__((ext_vector_type(8)));
typedef float f32x4 __attribute__((ext_vector_type(4)));
typedef float f32x16 __attribute__((ext_vector_type(16)));
typedef unsigned u32x4 __attribute__((ext_vector_type(4)));
typedef unsigned u32x2 __attribute__((ext_vector_type(2)));

constexpr int DM = 1024, NB = 16, SEQ = 2048, CB = 8, TC = CB * SEQ, NCH = NB / CB;
constexpr int LDP = 11264;
constexpr int C_AB = 0, C_AC = 512, C_AX = 1024, C_AZ = 1536, C_CQ = 2048, C_CKV = 2304, C_KPE = 2432, C_BZ = 2560,
              C_DQ = 3072, C_DK = 4608, C_DV = 6144, C_CZ = 7680, C_GATE = 8192;
constexpr int C_XRAW = 1024;
constexpr int C_MB = C_DQ;
constexpr int C_MACC = C_DK;
constexpr float EPS = 1e-6f;
constexpr float LOG2E = 1.4426950408889634f;

constexpr size_t W_IN = 0, W_UQ = (size_t)LDP * 1024 * 2, W_UKV = W_UQ + 768 * 256 * 2, W_OA = W_UKV + 1024 * 128 * 2,
                 W_OB = W_OA + 1024 * 512 * 2, W_OC = W_OB + 1024 * 512 * 2, W_O = W_OC + 1024 * 512 * 2, W_LAYER = W_O + 1024 * 1024 * 2;
constexpr size_t OFF_ROPE = 2 * W_LAYER, OFF_LSE = OFF_ROPE + 2048 * 16 * 8, OFF_SS = OFF_LSE + (size_t)TC * 24 * 4, OFF_SSX = OFF_SS + (size_t)TC * 8 * 4, OFF_R = OFF_SSX + (size_t)TC * 16 * 4;
constexpr size_t OFF_QB = OFF_R, OFF_KB = OFF_QB + (size_t)TC * 768 * 2, OFF_VB = OFF_KB + (size_t)TC * 768 * 2;
constexpr size_t OFF_XB = OFF_R;
constexpr size_t OFF_PROJ = OFF_VB + (size_t)TC * 512 * 2, OFF_BAR = OFF_PROJ + (size_t)TC * LDP * 2, WS_END = OFF_BAR + 16384;
static_assert(OFF_R % 256 == 0 && WS_END <= 536870912ull, "ws map");

typedef float f32x2_t __attribute__((ext_vector_type(2))); typedef __bf16 bf16x2_t __attribute__((ext_vector_type(2)));
__device__ __forceinline__ unsigned cvt_pk_bf16(float lo, float hi) { f32x2_t v = {lo, hi}; bf16x2_t b = __builtin_convertvector(v, bf16x2_t); return __builtin_bit_cast(unsigned, b); }
__device__ __forceinline__ float bf_lo(unsigned w) { return __uint_as_float(w << 16); }
__device__ __forceinline__ float bf_hi(unsigned w) { return __uint_as_float(w & 0xffff0000u); }
__device__ __forceinline__ float wave_sum(float v) {
#pragma unroll
    for (int o = 1; o < 64; o <<= 1) v += __shfl_xor(v, o);
    return v;
}
__device__ __forceinline__ float silu_f(float z) { return z * __builtin_amdgcn_rcpf(1.f + __expf(-z)); }
__device__ __forceinline__ float sigm_f(float z) { return __builtin_amdgcn_rcpf(1.f + __expf(-z)); }

namespace pg8 {
constexpr int BM = 256, BK = 64, HALF = 128, HTB = HALF * BK * 2, STAGE_BYTES = 8 * HTB, NXCD = 8, WGM = 8;
__host__ __device__ __forceinline__ int lds_byte(int r, int c) { const int st = (r >> 4) * 2 + (c >> 5), rr = r & 15, cc = c & 31, ob = rr * 64 + cc * 2; return st * 1024 + (ob ^ (((ob >> 9) & 1) << 5)); }
__host__ __device__ __forceinline__ void stage_rc(int b, int& R, int& C) { const int st = b / 1024, sb = b % 1024, swz = sb ^ (((sb >> 9) & 1) << 5); R = (st >> 1) * 16 + swz / 64; C = (st & 1) * 32 + (swz % 64) / 2; }
__host__ __device__ __forceinline__ int perm32(int rho) { const int n = rho >> 4, i = rho & 15; return 8 * (i >> 2) + 4 * n + (i & 3); }
struct Unit { int pm, pn, br; };
struct Gemm { const bf16_t* A; const bf16_t* Bt; int M, N, K, lda, ldb; };
struct StaticOrder {
    int nM, nN, nwg, G, c;
    __device__ void init(int M, int N, int G_, int c_) { nM = M / BM; nN = N / BM; nwg = nM * nN; G = G_; c = c_; }
    __device__ bool next(int i, Unit& u) const {
        const long L = (long)i * G + c; if (L >= nwg) return false;
        int wgid = (int)L; { const int q = nwg / NXCD, r = nwg % NXCD, xcd = wgid % NXCD, off = wgid / NXCD; wgid = (xcd < r ? xcd * (q + 1) : r * (q + 1) + (xcd - r) * q) + off; }
        const int nig = WGM * nN, gid = wgid / nig, fm = gid * WGM, gsz = (nM - fm) < WGM ? (nM - fm) : WGM;
        u.pm = fm + ((wgid % nig) % gsz); u.pn = (wgid % nig) / gsz; u.br = 0; return true;
    }
    __device__ __forceinline__ size_t aoff(const Unit&) const { return 0; }
    __device__ __forceinline__ size_t boff(const Unit&) const { return 0; }
};
struct MergeOrder {
    StaticOrder base;
    __device__ bool next(int i, Unit& u) const { const int ti = i / 3; if (!base.next(ti, u)) return false; u.br = i - 3 * ti; return true; }
    __device__ __forceinline__ size_t aoff(const Unit& u) const { return (size_t)(u.br == 0 ? C_AB : (u.br == 1 ? C_BZ : C_CZ)) * 2; }
    __device__ __forceinline__ size_t boff(const Unit& u) const { return (size_t)u.br * (1024 * 512 * 2); }
};

template <class Epi, class Sched, bool ALIGN_EPI = true, bool SP2 = true>
__device__ __forceinline__ void gemm_phase(LAS unsigned char* lds, const Gemm g, const Sched& S, const Epi& E, const int tid) {
    const int wid = __builtin_amdgcn_readfirstlane(tid >> 6), lane = tid & 63, wr = wid >> 2, wc = wid & 3, fr = lane & 15, fq = lane >> 4;
    const int K = g.K, nt = K / BK;
    unsigned voffA[2], voffB[2];
#pragma unroll
    for (int i = 0; i < 2; ++i) { int R, C; stage_rc(tid * 16 + i * 8192, R, C); const int Rb = (R & ~31) + perm32(R & 31);
        voffA[i] = (unsigned)(R * g.lda + C) * 2u; voffB[i] = (unsigned)(Rb * g.ldb + C) * 2u; }
    const size_t kstep = (size_t)(BK * 2);
    const size_t hstepA = (size_t)HALF * g.lda * 2, hstepB = (size_t)HALF * g.ldb * 2;
    const size_t tstepA = 2 * hstepA, tstepB = 2 * hstepB;
    const unsigned ldsw = (unsigned)wid * 1024u;
    const int aoff = lds_byte(wr * 64 + fr, fq * 8), boff = lds_byte(wc * 32 + fr, fq * 8);
#define PG8_SA(b, h) (((b) * 2 + (h)) * HTB)
#define PG8_SB(b, h) ((4 + (b) * 2 + (h)) * HTB)
#define PG8_STAGE(bufoff, gbase, voff) do { _Pragma("unroll") for (int _i = 0; _i < 2; ++_i) \
        __builtin_amdgcn_global_load_lds((const unsigned*)((const char*)(gbase) + (voff)[_i]), (LAS unsigned*)(lds + (bufoff) + ldsw + _i * 8192), 16, 0, 0); } while (0)
#define PG8_LDA(dst, b, h) do { _Pragma("unroll") for (int m = 0; m < 4; ++m) _Pragma("unroll") for (int k = 0; k < 2; ++k) dst[m][k] = *(const LAS bf16x8*)(lds + PG8_SA(b, h) + aoff + m * 2048 + k * 1024); } while (0)
#define PG8_LDB(dst, b, h) do { _Pragma("unroll") for (int n = 0; n < 2; ++n) _Pragma("unroll") for (int k = 0; k < 2; ++k) dst[n][k] = *(const LAS bf16x8*)(lds + PG8_SB(b, h) + boff + n * 2048 + k * 1024); } while (0)
#define PG8_MMA(ai, bj, At, Bt) do { __builtin_amdgcn_s_setprio(1); _Pragma("unroll") for (int m = 0; m < 4; ++m) _Pragma("unroll") for (int n = 0; n < 2; ++n) _Pragma("unroll") for (int k = 0; k < 2; ++k) \
        acc[ai][bj][m][n] = __builtin_amdgcn_mfma_f32_16x16x32_bf16(Bt[n][k], At[m][k], acc[ai][bj][m][n], 0, 0, 0); __builtin_amdgcn_s_setprio(0); } while (0)
#define PG8_WAIT_V(n) asm volatile("s_waitcnt vmcnt(" #n ")" ::: "memory")
#define PG8_WAIT_L(n) asm volatile("s_waitcnt lgkmcnt(" #n ")" ::: "memory")
#define PG8_BAR __builtin_amdgcn_s_barrier()
#define PG8_SCHED __builtin_amdgcn_sched_barrier(0)
    Unit cur, nxt; int ui = 0;
    if (!S.next(0, cur)) return;
    f32x4 acc[2][2][4][2];
#pragma unroll
    for (int a = 0; a < 2; ++a)
#pragma unroll
        for (int b = 0; b < 2; ++b)
#pragma unroll
            for (int m = 0; m < 4; ++m)
#pragma unroll
                for (int n = 0; n < 2; ++n) acc[a][b][m][n] = (f32x4){0.f, 0.f, 0.f, 0.f};
    bf16x8 At[4][2], B0[2][2], B1[2][2];
    const char* cA = (const char*)g.A + (size_t)cur.pm * tstepA + S.aoff(cur); const char* cB = (const char*)g.Bt + (size_t)cur.pn * tstepB + S.boff(cur);
    static_assert(SP2, "only the SP2 loop is kept");
    PG8_STAGE(PG8_SB(0, 0), cB, voffB); PG8_STAGE(PG8_SB(0, 1), cB + hstepB, voffB); PG8_STAGE(PG8_SA(0, 0), cA, voffA); PG8_STAGE(PG8_SA(0, 1), cA + hstepA, voffA);
    if (wr == 1) PG8_BAR;
    PG8_WAIT_V(2); PG8_BAR;
    PG8_STAGE(PG8_SB(1, 0), cB + kstep, voffB); PG8_STAGE(PG8_SA(1, 0), cA + kstep, voffA); PG8_STAGE(PG8_SB(1, 1), cB + hstepB + kstep, voffB);
    PG8_WAIT_V(6); PG8_BAR;
    for (;;) {
        const bool has_next = S.next(ui + 1, nxt);
        const char* nA = has_next ? (const char*)g.A + (size_t)nxt.pm * tstepA + S.aoff(nxt) : cA; const char* nB = has_next ? (const char*)g.Bt + (size_t)nxt.pn * tstepB + S.boff(nxt) : cB;
#pragma nounroll
        for (int t = 0; t < nt; t += 2) {
            const bool last = (t == nt - 2);
            const char* a1 = cA + (size_t)(t + 1) * kstep;
            const char* a2 = last ? nA : cA + (size_t)(t + 2) * kstep; const char* b2 = last ? nB : cB + (size_t)(t + 2) * kstep;
            const char* a3 = a2 + kstep; const char* b3 = b2 + kstep;
            PG8_LDB(B0, 0, 0); PG8_LDB(B1, 0, 1); PG8_SCHED; PG8_LDA(At, 0, 0); PG8_STAGE(PG8_SA(1, 1), a1 + hstepA, voffA);
            PG8_WAIT_V(8); PG8_WAIT_L(0); PG8_BAR; PG8_MMA(0, 0, At, B0); PG8_MMA(0, 1, At, B1); PG8_BAR; PG8_SCHED;
            PG8_LDA(At, 0, 1); PG8_STAGE(PG8_SB(0, 0), b2, voffB); PG8_STAGE(PG8_SB(0, 1), b2 + hstepB, voffB); PG8_STAGE(PG8_SA(0, 0), a2, voffA);
            PG8_WAIT_V(8); PG8_WAIT_L(0); PG8_BAR; PG8_MMA(1, 0, At, B0); PG8_MMA(1, 1, At, B1); PG8_BAR; PG8_SCHED;
            PG8_LDB(B0, 1, 0); PG8_LDB(B1, 1, 1); PG8_SCHED; PG8_LDA(At, 1, 0); PG8_STAGE(PG8_SA(0, 1), a2 + hstepA, voffA);
            PG8_WAIT_V(8); PG8_WAIT_L(0); PG8_BAR; PG8_MMA(0, 0, At, B0); PG8_MMA(0, 1, At, B1); PG8_BAR; PG8_SCHED;
            PG8_LDA(At, 1, 1); PG8_STAGE(PG8_SB(1, 0), b3, voffB); PG8_STAGE(PG8_SB(1, 1), b3 + hstepB, voffB); PG8_STAGE(PG8_SA(1, 0), a3, voffA);
            PG8_WAIT_V(8); PG8_WAIT_L(0); PG8_BAR; PG8_MMA(1, 0, At, B0); PG8_MMA(1, 1, At, B1); PG8_BAR; PG8_SCHED;
        }
        if constexpr (ALIGN_EPI) { if (wr == 0) PG8_BAR; }
        E(acc, cur, wr, wc, fr, fq);
        if (!has_next) break;
#pragma unroll
        for (int a = 0; a < 2; ++a)
#pragma unroll
            for (int b = 0; b < 2; ++b)
#pragma unroll
                for (int m = 0; m < 4; ++m)
#pragma unroll
                    for (int n = 0; n < 2; ++n) acc[a][b][m][n] = (f32x4){0.f, 0.f, 0.f, 0.f};
        cur = nxt; cA = nA; cB = nB; ++ui;
        if constexpr (ALIGN_EPI) { if (wr == 1) PG8_BAR; }
    }
    PG8_WAIT_V(0);
    if constexpr (!ALIGN_EPI) { if (wr == 0) PG8_BAR; }
    PG8_BAR;
#undef PG8_SA
#undef PG8_SB
#undef PG8_STAGE
#undef PG8_LDA
#undef PG8_LDB
#undef PG8_MMA
#undef PG8_WAIT_V
#undef PG8_WAIT_L
#undef PG8_BAR
#undef PG8_SCHED
}

struct EpiPlain {
    bf16_t* O; int ldc;
    __device__ __forceinline__ void operator()(const f32x4 (&acc)[2][2][4][2], const Unit& u, int wr, int wc, int fr, int fq) const {
        const int row0 = u.pm * BM + wr * 64 + fr, col0 = u.pn * BM + wc * 32 + 8 * fq;
#pragma unroll
        for (int ai = 0; ai < 2; ++ai)
#pragma unroll
            for (int m = 0; m < 4; ++m) { bf16_t* rowp = O + (size_t)(row0 + ai * HALF + m * 16) * ldc + col0;
#pragma unroll
                for (int bj = 0; bj < 2; ++bj) { const f32x4 v0 = acc[ai][bj][m][0], v1 = acc[ai][bj][m][1]; u32x4 w;
                    w.x = cvt_pk_bf16(v0[0], v0[1]); w.y = cvt_pk_bf16(v0[2], v0[3]); w.z = cvt_pk_bf16(v1[0], v1[1]); w.w = cvt_pk_bf16(v1[2], v1[3]);
                    *(u32x4*)(rowp + bj * HALF) = w; } }
    }
};
struct EpiProj {
    bf16_t* O; const float* gq; const float* gk;
    float* ss; bool st;
    __device__ __forceinline__ void operator()(const f32x4 (&acc)[2][2][4][2], const Unit& u, int wr, int wc, int fr, int fq) const {
        const int row0 = u.pm * BM + wr * 64 + fr, col0 = u.pn * BM + wc * 64 + 8 * fq;
        if (u.pn < 8) {
            const int ch0 = 64 * u.pn + 16 * wc + 4 * fq;
#pragma unroll
            for (int ai = 0; ai < 2; ++ai)
#pragma unroll
                for (int m = 0; m < 4; ++m) { const int row = u.pm * BM + wr * 64 + fr + ai * HALF + m * 16;
                    const f32x4 ab = acc[ai][0][m][0], ac = acc[ai][0][m][1], ax = acc[ai][1][m][0], az = acc[ai][1][m][1];
                    f32x4 gz, uu = ac * ax;
#pragma unroll
                    for (int i = 0; i < 4; ++i) gz[i] = ab[i] * silu_f(az[i]);
                    bf16_t* rowp = O + (size_t)row * LDP + ch0;
                    if (st) { *(u32x2*)(rowp + C_AB) = (u32x2){cvt_pk_bf16(gz[0], gz[1]), cvt_pk_bf16(gz[2], gz[3])}; *(u32x2*)(rowp + C_AC) = (u32x2){cvt_pk_bf16(uu[0], uu[1]), cvt_pk_bf16(uu[2], uu[3])}; }
                    else asm volatile("" :: "v"(gz), "v"(uu)); }
            return;
        }
        const bool nrm = (u.pn >= 12 && u.pn < 24);
        const bool stat = (u.pn == 8) || (u.pn == 9 && wc < 3);
        f32x4 gv[2][2];
        if (nrm) { const bool isq = u.pn < 18; const int gi = ((u.pn - 12) % 6) >> 1; const float* gp = (isq ? gq : gk) + gi * 64 + 8 * fq; const float post = isq ? 0.125f * LOG2E : 1.f;
#pragma unroll
            for (int bj = 0; bj < 2; ++bj)
#pragma unroll
                for (int n = 0; n < 2; ++n) gv[bj][n] = *(const f32x4*)(gp + bj * 32 + n * 4) * post;
        } else {
#pragma unroll
            for (int bj = 0; bj < 2; ++bj)
#pragma unroll
                for (int n = 0; n < 2; ++n) gv[bj][n] = (f32x4){1.f, 1.f, 1.f, 1.f};
        }
#pragma unroll
        for (int ai = 0; ai < 2; ++ai)
#pragma unroll
            for (int m = 0; m < 4; ++m) {
                const int row = row0 + ai * HALF + m * 16;
                f32x4 v[2][2];
#pragma unroll
                for (int bj = 0; bj < 2; ++bj)
#pragma unroll
                    for (int n = 0; n < 2; ++n) v[bj][n] = acc[ai][bj][m][n];
                float r = 1.f;
                if (nrm || stat) { float ss_ = 0.f;
#pragma unroll
                    for (int bj = 0; bj < 2; ++bj)
#pragma unroll
                        for (int n = 0; n < 2; ++n) { const f32x4 x = v[bj][n]; ss_ += (x[0] * x[0] + x[1] * x[1]) + (x[2] * x[2] + x[3] * x[3]); }
                    ss_ += __shfl_xor(ss_, 16); ss_ += __shfl_xor(ss_, 32);
                    if (nrm) r = rsqrtf(ss_ * (1.f / 64.f) + EPS);
                    else if (fq == 0) ss[(size_t)row * 8 + (u.pn == 8 ? wc : 4 + wc)] = ss_; }
                bf16_t* rowp = O + (size_t)row * LDP + col0;
#pragma unroll
                for (int bj = 0; bj < 2; ++bj) { const f32x4 v0 = v[bj][0] * r * gv[bj][0], v1 = v[bj][1] * r * gv[bj][1]; u32x4 w;
                    w.x = cvt_pk_bf16(v0[0], v0[1]); w.y = cvt_pk_bf16(v0[2], v0[3]); w.z = cvt_pk_bf16(v1[0], v1[1]); w.w = cvt_pk_bf16(v1[2], v1[3]);
                    if (st) *(u32x4*)(rowp + bj * 32) = w; else asm volatile("" :: "v"(w)); } }
    }
};
struct EpiKV {
    bf16_t* KBo; bf16_t* VBo; const bf16_t* proj; const float* ss; const float* gk; const float* rope;
    __device__ __forceinline__ void operator()(const f32x4 (&acc)[2][2][4][2], const Unit& u, int wr, int wc, int fr, int fq) const {
        const int row0 = u.pm * BM + wr * 64 + fr; const int wu = 4 * u.pn + wc;
        if (wu < 8) {
            f32x4 gv[2][2];
#pragma unroll
            for (int bj = 0; bj < 2; ++bj)
#pragma unroll
                for (int n = 0; n < 2; ++n) gv[bj][n] = *(const f32x4*)(gk + bj * 32 + 8 * fq + n * 4);
            const f32x4 g1 = *(const f32x4*)(gk + 64 + 4 * fq), g2 = *(const f32x4*)(gk + 80 + 4 * fq);
#pragma unroll
            for (int ai = 0; ai < 2; ++ai) {
                f32x4 s4h[4];
#pragma unroll
                for (int m = 0; m < 4; ++m) s4h[m] = *(const f32x4*)(ss + (size_t)(row0 + ai * HALF + m * 16) * 8 + 4);
                __builtin_amdgcn_sched_barrier(0);
#pragma unroll
                for (int m = 0; m < 4; ++m) {
                    const int row = row0 + ai * HALF + m * 16;
                    const f32x4 s4 = s4h[m];
                    const float rkv = rsqrtf((s4.x + s4.y) * (1.f / 128.f) + EPS);
                    f32x4 v[2][2]; float q = 0.f;
#pragma unroll
                    for (int bj = 0; bj < 2; ++bj)
#pragma unroll
                        for (int n = 0; n < 2; ++n) { v[bj][n] = acc[ai][bj][m][n] * rkv; const f32x4 x = v[bj][n]; q += (x[0] * x[0] + x[1] * x[1]) + (x[2] * x[2] + x[3] * x[3]); }
                    q += __shfl_xor(q, 16); q += __shfl_xor(q, 32);
                    const float rk = rsqrtf((q + s4.z) * (1.f / 96.f) + EPS);
                    bf16_t* kr = KBo + (size_t)row * 768 + 96 * wu;
#pragma unroll
                    for (int bj = 0; bj < 2; ++bj) { const f32x4 v0 = v[bj][0] * rk * gv[bj][0], v1 = v[bj][1] * rk * gv[bj][1]; u32x4 w;
                        w.x = cvt_pk_bf16(v0[0], v0[1]); w.y = cvt_pk_bf16(v0[2], v0[3]); w.z = cvt_pk_bf16(v1[0], v1[1]); w.w = cvt_pk_bf16(v1[2], v1[3]);
                        *(u32x4*)(kr + bj * 32 + 8 * fq) = w; }
                    const bf16_t* pe = proj + (size_t)row * LDP + C_KPE;
                    const u32x2 a = *(const u32x2*)(pe + 4 * fq), b = *(const u32x2*)(pe + 16 + 4 * fq);
                    const int pos = row & (SEQ - 1);
                    const f32x4 cs0 = *(const f32x4*)(rope + (size_t)(pos * 16 + 4 * fq) * 2), cs1 = *(const f32x4*)(rope + (size_t)(pos * 16 + 4 * fq) * 2 + 4);
                    const f32x4 t1 = (f32x4){bf_lo(a.x), bf_hi(a.x), bf_lo(a.y), bf_hi(a.y)} * g1 * rk, t2 = (f32x4){bf_lo(b.x), bf_hi(b.x), bf_lo(b.y), bf_hi(b.y)} * g2 * rk;
                    const f32x4 cc = (f32x4){cs0.x, cs0.z, cs1.x, cs1.z}, sn = (f32x4){cs0.y, cs0.w, cs1.y, cs1.w};
                    const f32x4 o1 = t1 * cc - t2 * sn, o2 = t2 * cc + t1 * sn;
                    *(u32x2*)(kr + 64 + 4 * fq) = (u32x2){cvt_pk_bf16(o1[0], o1[1]), cvt_pk_bf16(o1[2], o1[3])};
                    *(u32x2*)(kr + 80 + 4 * fq) = (u32x2){cvt_pk_bf16(o2[0], o2[1]), cvt_pk_bf16(o2[2], o2[3])};
                }
            }
        } else {
            typedef float f32x2v __attribute__((ext_vector_type(2)));
            f32x2v s2v[2][4];
#pragma unroll
            for (int ai = 0; ai < 2; ++ai)
#pragma unroll
                for (int m = 0; m < 4; ++m) s2v[ai][m] = *(const f32x2v*)(ss + (size_t)(row0 + ai * HALF + m * 16) * 8 + 4);
            __builtin_amdgcn_sched_barrier(0);
#pragma unroll
            for (int ai = 0; ai < 2; ++ai)
#pragma unroll
                for (int m = 0; m < 4; ++m) {
                    const int row = row0 + ai * HALF + m * 16;
                    const float rkv = rsqrtf((s2v[ai][m].x + s2v[ai][m].y) * (1.f / 128.f) + EPS);
                    bf16_t* vr = VBo + (size_t)row * 512 + 64 * (wu - 8);
#pragma unroll
                    for (int bj = 0; bj < 2; ++bj) { const f32x4 v0 = acc[ai][bj][m][0] * rkv, v1 = acc[ai][bj][m][1] * rkv; u32x4 w;
                        w.x = cvt_pk_bf16(v0[0], v0[1]); w.y = cvt_pk_bf16(v0[2], v0[3]); w.z = cvt_pk_bf16(v1[0], v1[1]); w.w = cvt_pk_bf16(v1[2], v1[3]);
                        *(u32x4*)(vr + bj * 32 + 8 * fq) = w; } }
        }
    }
};
struct EpiMerge {
    const bf16_t* proj; const float* bgate;
    __device__ __forceinline__ void operator()(const f32x4 (&acc)[2][2][4][2], const Unit& u, int wr, int wc, int fr, int fq) const {
        const int row0 = u.pm * BM + wr * 64 + fr, col0 = u.pn * BM + wc * 32 + 8 * fq; const int BR = u.br;
        f32x4 bg[2][2];
#pragma unroll
        for (int bj = 0; bj < 2; ++bj)
#pragma unroll
            for (int n = 0; n < 2; ++n) bg[bj][n] = *(const f32x4*)(bgate + BR * 1024 + col0 + bj * HALF + n * 4);
        const bool first = BR == 0, last = BR == 2;
        const int dcol = last ? C_MB : C_MACC;
        u32x4 gS[2][2], pS[2][2];
#define MG_LOAD(R, SET) do { const size_t rb_ = (size_t)(row0 + ((R) >> 2) * HALF + ((R) & 3) * 16) * LDP; \
            _Pragma("unroll") for (int bj_ = 0; bj_ < 2; ++bj_) { const int c_ = col0 + bj_ * HALF; \
                gS[SET][bj_] = *(const u32x4*)(proj + rb_ + C_GATE + BR * 1024 + c_); pS[SET][bj_] = *(const u32x4*)(proj + rb_ + C_MACC + c_); } } while (0)
        MG_LOAD(0, 0);
#pragma unroll
        for (int r = 0; r < 8; ++r) {
            const int ai = r >> 2, m = r & 3;
            if (r + 1 < 8) { if ((r & 1) == 0) MG_LOAD(r + 1, 1); else MG_LOAD(r + 1, 0); }
            __builtin_amdgcn_sched_barrier(0);
#pragma unroll
            for (int bj = 0; bj < 2; ++bj) { const size_t rb = (size_t)(row0 + ai * HALF + m * 16) * LDP; const int c = col0 + bj * HALF;
                const u32x4 g = gS[r & 1][bj], p = pS[r & 1][bj];
                f32x4 g0 = (f32x4){bf_lo(g.x), bf_hi(g.x), bf_lo(g.y), bf_hi(g.y)} + bg[bj][0], g1 = (f32x4){bf_lo(g.z), bf_hi(g.z), bf_lo(g.w), bf_hi(g.w)} + bg[bj][1];
#pragma unroll
                for (int i = 0; i < 4; ++i) { g0[i] = sigm_f(g0[i]); g1[i] = sigm_f(g1[i]); }
                f32x4 v0 = acc[ai][bj][m][0] * g0, v1 = acc[ai][bj][m][1] * g1;
                const f32x4 p0 = (f32x4){bf_lo(p.x), bf_hi(p.x), bf_lo(p.y), bf_hi(p.y)}, p1 = (f32x4){bf_lo(p.z), bf_hi(p.z), bf_lo(p.w), bf_hi(p.w)};
#pragma unroll
                for (int i = 0; i < 4; ++i) { v0[i] += first ? 0.f : p0[i]; v1[i] += first ? 0.f : p1[i]; }
                u32x4 w; w.x = cvt_pk_bf16(v0[0], v0[1]); w.y = cvt_pk_bf16(v0[2], v0[3]); w.z = cvt_pk_bf16(v1[0], v1[1]); w.w = cvt_pk_bf16(v1[2], v1[3]);
                *(u32x4*)(const_cast<bf16_t*>(proj) + rb + dcol + c) = w; }
            __builtin_amdgcn_sched_barrier(0);
        }
#undef MG_LOAD
    }
};
template <bool BF_IN> struct EpiRes {
    const float* xin; const bf16_t* xinb; float* out; bf16_t* xb; float* ssx;
    __device__ __forceinline__ void operator()(const f32x4 (&acc)[2][2][4][2], const Unit& u, int wr, int wc, int fr, int fq) const {
        const int row0 = u.pm * BM + wr * 64 + fr, col0 = u.pn * BM + wc * 32 + 8 * fq;
#pragma unroll
        for (int aq = 0; aq < 4; ++aq) { const int ai = aq >> 1, m0 = (aq & 1) * 2;
            f32x4 xa[2][2], xc[2][2];
#pragma unroll
            for (int mm = 0; mm < 2; ++mm)
#pragma unroll
                for (int bj = 0; bj < 2; ++bj) { const int row = row0 + ai * HALF + (m0 + mm) * 16;
                    if (BF_IN) { const u32x4 w = *(const u32x4*)(xinb + (size_t)row * LDP + col0 + bj * HALF);
                        xa[mm][bj] = (f32x4){bf_lo(w.x), bf_hi(w.x), bf_lo(w.y), bf_hi(w.y)}; xc[mm][bj] = (f32x4){bf_lo(w.z), bf_hi(w.z), bf_lo(w.w), bf_hi(w.w)}; }
                    else { const size_t off = (size_t)row * DM + col0 + bj * HALF; xa[mm][bj] = *(const f32x4*)(xin + off); xc[mm][bj] = *(const f32x4*)(xin + off + 4); } }
            __builtin_amdgcn_sched_barrier(0);
#pragma unroll
            for (int mm = 0; mm < 2; ++mm) { const int m = m0 + mm; const int row = row0 + ai * HALF + m * 16; const size_t off = (size_t)row * DM + col0; float q = 0.f;
#pragma unroll
                for (int bj = 0; bj < 2; ++bj) { const f32x4 a = xa[mm][bj] + acc[ai][bj][m][0], b = xc[mm][bj] + acc[ai][bj][m][1];
                    if (BF_IN) { *(f32x4*)(out + off + bj * HALF) = a; *(f32x4*)(out + off + bj * HALF + 4) = b; }
                    else { q += (a[0] * a[0] + a[1] * a[1]) + (a[2] * a[2] + a[3] * a[3]) + (b[0] * b[0] + b[1] * b[1]) + (b[2] * b[2] + b[3] * b[3]);
                        u32x4 w; w.x = cvt_pk_bf16(a[0], a[1]); w.y = cvt_pk_bf16(a[2], a[3]); w.z = cvt_pk_bf16(b[0], b[1]); w.w = cvt_pk_bf16(b[2], b[3]);
                        *(u32x4*)(xb + (size_t)row * LDP + col0 + bj * HALF) = w; } }
                if (!BF_IN) { q += __shfl_xor(q, 16); q += __shfl_xor(q, 32); if (fq == 0) ssx[(size_t)row * 16 + 4 * u.pn + wc] = q; } }
            __builtin_amdgcn_sched_barrier(0);
        }
    }
};
}

struct HalfWork {
    const bf16_t *Q, *K, *V; bf16_t* O; float* lse;
    int rsq, rsk, rsv, rso, rsl;
    float slope2; int nback;
    const float *ssq, *gqn, *rope;
    int q0A, tloA, nA, q0B, tloB, nB;
};
template <int DK, bool MLA>
__device__ __forceinline__ void attn_core(LAS unsigned char* lds, const HalfWork& W, const int NS, const int tid, const bool do_store = true) {
    const int lane = tid & 63, r32 = lane & 31, hi = lane >> 5;
    const int wid = __builtin_amdgcn_readfirstlane(tid >> 6), hf = wid >> 2, w4 = wid & 3, ht = tid & 255;
    constexpr int KSTR = DK * 2 + 16, VSTR = 136, KBYTES = 64 * KSTR, BUFB = KBYTES + 64 * VSTR;
    constexpr int KP = DK / 8, KPT = (64 * KP) / 256;
    LAS unsigned char* hb = lds + hf * (2 * BUFB);
    u32x4 kreg[KPT], vreg[2];
    bf16x8 qf[DK / 16];
    float m_run = -INFINITY, l_run = 0.f; f32x16 o0 = {}, o1 = {};
    const int ntot = W.nA + W.nB;
#define ATT_LOADT(s) do { const bool a_ = (s) < W.nA; const int t_ = a_ ? (W.tloA + (s)) : (W.tloB + (s) - W.nA); \
        const bf16_t* kp_ = W.K + (long)(64 * t_) * W.rsk; const bf16_t* vp_ = W.V + (long)(64 * t_) * W.rsv; \
        _Pragma("unroll") for (int i_ = 0; i_ < KPT; ++i_) { const int idx_ = ht + 256 * i_, row_ = idx_ / KP, ch_ = idx_ % KP; kreg[i_] = *(const u32x4*)(kp_ + (long)row_ * W.rsk + ch_ * 8); } \
        _Pragma("unroll") for (int i_ = 0; i_ < 2; ++i_) { const int idx_ = ht + 256 * i_, row_ = idx_ >> 3, ch_ = idx_ & 7; vreg[i_] = *(const u32x4*)(vp_ + (long)row_ * W.rsv + ch_ * 8); } } while (0)
#define ATT_WRITET(buf) do { LAS unsigned char* kb_ = hb + (buf) * BUFB; \
        _Pragma("unroll") for (int i_ = 0; i_ < KPT; ++i_) { const int idx_ = ht + 256 * i_, row_ = idx_ / KP, ch_ = idx_ % KP; *(LAS u32x4*)(kb_ + row_ * KSTR + ch_ * 16) = kreg[i_]; } \
        _Pragma("unroll") for (int i_ = 0; i_ < 2; ++i_) { const int idx_ = ht + 256 * i_, row_ = idx_ >> 3, ch_ = idx_ & 7; \
            _Pragma("unroll") for (int e_ = 0; e_ < 8; ++e_) { const unsigned w_ = vreg[i_][e_ >> 1]; \
                *(LAS unsigned short*)(kb_ + KBYTES + (8 * ch_ + e_) * VSTR + row_ * 2) = (unsigned short)((e_ & 1) ? (w_ >> 16) : (w_ & 0xffffu)); } } } while (0)
    if (ntot > 0) { ATT_LOADT(0); ATT_WRITET(0); }
    __syncthreads();
    for (int s = 0; s < NS; ++s) {
        if (s + 1 < ntot) ATT_LOADT(s + 1);
        if (s < ntot) {
            const bool inA = s < W.nA; const int js = inA ? s : s - W.nA;
            const int q0 = inA ? W.q0A : W.q0B; const int t = (inA ? W.tloA : W.tloB) + js; const int nj = inA ? W.nA : W.nB;
            const int qrow = q0 + w4 * 32 + r32;
            if (js == 0) {
                const bf16_t* qp = W.Q + (long)qrow * W.rsq + hi * 8;
#pragma unroll
                for (int ds = 0; ds < DK / 16; ++ds) qf[ds] = *(const bf16x8*)(qp + ds * 16);
                m_run = -INFINITY; l_run = 0.f; o0 = (f32x16){}; o1 = (f32x16){};
                if (MLA) {
                    float qv[DK / 16][8]; float ssl = 0.f;
#pragma unroll
                    for (int ds = 0; ds < DK / 16; ++ds) { const u32x4 w = __builtin_bit_cast(u32x4, qf[ds]);
#pragma unroll
                        for (int e = 0; e < 4; ++e) { qv[ds][2 * e] = bf_lo(w[e]); qv[ds][2 * e + 1] = bf_hi(w[e]); ssl += qv[ds][2 * e] * qv[ds][2 * e] + qv[ds][2 * e + 1] * qv[ds][2 * e + 1]; } }
                    ssl += __shfl_xor(ssl, 32);
                    const f32x4 s4 = *(const f32x4*)(W.ssq + (size_t)qrow * 8);
                    const float rq = rsqrtf(((s4.x + s4.y) + (s4.z + s4.w)) * (1.f / 256.f) + EPS);
                    const float rn = rsqrtf(ssl * rq * rq * (1.f / 96.f) + EPS) * rq * (0.10206207261596575f * LOG2E);
#pragma unroll
                    for (int ds = 0; ds < DK / 16; ++ds) { const f32x4 ga = *(const f32x4*)(W.gqn + 16 * ds + 8 * hi), gb = *(const f32x4*)(W.gqn + 16 * ds + 8 * hi + 4);
#pragma unroll
                        for (int e = 0; e < 4; ++e) { qv[ds][e] *= rn * ga[e]; qv[ds][4 + e] *= rn * gb[e]; } }
                    const float* rp = W.rope + (size_t)(qrow * 16 + 8 * hi) * 2;
#pragma unroll
                    for (int e2 = 0; e2 < 4; ++e2) { const f32x4 cs = *(const f32x4*)(rp + 4 * e2);
                        { const float t1 = qv[DK / 16 - 2][2 * e2], t2 = qv[DK / 16 - 1][2 * e2]; qv[DK / 16 - 2][2 * e2] = t1 * cs.x - t2 * cs.y; qv[DK / 16 - 1][2 * e2] = t2 * cs.x + t1 * cs.y; }
                        { const float t1 = qv[DK / 16 - 2][2 * e2 + 1], t2 = qv[DK / 16 - 1][2 * e2 + 1]; qv[DK / 16 - 2][2 * e2 + 1] = t1 * cs.z - t2 * cs.w; qv[DK / 16 - 1][2 * e2 + 1] = t2 * cs.z + t1 * cs.w; } }
#pragma unroll
                    for (int ds = 0; ds < DK / 16; ++ds) { u32x4 w;
#pragma unroll
                        for (int e = 0; e < 4; ++e) w[e] = cvt_pk_bf16(qv[ds][2 * e], qv[ds][2 * e + 1]);
                        qf[ds] = __builtin_bit_cast(bf16x8, w); }
                }
            }
            const int qs = q0 + w4 * 32;
            const bool useful = (64 * t <= qs + 31) && (64 * t + 63 >= qs - W.nback);
            if (useful) {
                LAS const unsigned char* Kl = hb + (s & 1) * BUFB; LAS const unsigned char* Vl = Kl + KBYTES;
                f32x16 p0 = {}, p1 = {};
                bf16x8 kfa[DK / 16], kfb[DK / 16];
#pragma unroll
                for (int ds = 0; ds < DK / 16; ++ds) {
                    kfa[ds] = *(LAS const bf16x8*)(Kl + r32 * KSTR + ds * 32 + hi * 16);
                    kfb[ds] = *(LAS const bf16x8*)(Kl + (32 + r32) * KSTR + ds * 32 + hi * 16);
                }
                __builtin_amdgcn_sched_barrier(0);
#pragma unroll
                for (int ds = 0; ds < DK / 16; ++ds) {
                    p0 = __builtin_amdgcn_mfma_f32_32x32x16_bf16(kfa[ds], qf[ds], p0, 0, 0, 0);
                    p1 = __builtin_amdgcn_mfma_f32_32x32x16_bf16(kfb[ds], qf[ds], p1, 0, 0, 0);
                }
                u32x4 vfa[4], vfb[4];
#pragma unroll
                for (int ks = 0; ks < 4; ++ks) {
                    { LAS const unsigned char* va = Vl + r32 * VSTR + (16 * ks + 4 * hi) * 2; const u32x2 lo = *(LAS const u32x2*)va, hh = *(LAS const u32x2*)(va + 16); vfa[ks] = (u32x4){lo.x, lo.y, hh.x, hh.y}; }
                    { LAS const unsigned char* va = Vl + (32 + r32) * VSTR + (16 * ks + 4 * hi) * 2; const u32x2 lo = *(LAS const u32x2*)va, hh = *(LAS const u32x2*)(va + 16); vfb[ks] = (u32x4){lo.x, lo.y, hh.x, hh.y}; }
                }
                __builtin_amdgcn_sched_barrier(0);
                const bool full = MLA && (64 * t + 63 <= qs);
                if (!full) {
                    const int kb = 64 * t + 4 * hi;
#pragma unroll
                    for (int r = 0; r < 16; ++r) { const int d0 = qrow - (kb + (r & 3) + 8 * (r >> 2)), d1 = d0 - 32;
                        p0[r] = (d0 >= 0 && d0 <= W.nback) ? (MLA ? p0[r] : p0[r] - W.slope2 * (float)d0) : -INFINITY;
                        p1[r] = (d1 >= 0 && d1 <= W.nback) ? (MLA ? p1[r] : p1[r] - W.slope2 * (float)d1) : -INFINITY; }
                }
                float mx = fmaxf(p0[0], p1[0]);
#pragma unroll
                for (int r = 1; r < 16; ++r) mx = fmaxf(mx, fmaxf(p0[r], p1[r]));
                mx = fmaxf(mx, __shfl_xor(mx, 32));
                const float mnew = fmaxf(m_run, mx);
                const float muse = (mnew == -INFINITY) ? 0.f : mnew;
                const float alpha = __builtin_amdgcn_exp2f(m_run - muse);
                m_run = mnew;
                float rs = 0.f;
#pragma unroll
                for (int r = 0; r < 16; ++r) { p0[r] = __builtin_amdgcn_exp2f(p0[r] - muse); p1[r] = __builtin_amdgcn_exp2f(p1[r] - muse); rs += p0[r] + p1[r]; }
                l_run = l_run * alpha + rs;
#pragma unroll
                for (int r = 0; r < 16; ++r) { o0[r] *= alpha; o1[r] *= alpha; }
                u32x4 pw[4];
#pragma unroll
                for (int e = 0; e < 4; ++e) { pw[0][e] = cvt_pk_bf16(p0[2 * e], p0[2 * e + 1]); pw[1][e] = cvt_pk_bf16(p0[8 + 2 * e], p0[9 + 2 * e]);
                    pw[2][e] = cvt_pk_bf16(p1[2 * e], p1[2 * e + 1]); pw[3][e] = cvt_pk_bf16(p1[8 + 2 * e], p1[9 + 2 * e]); }
#pragma unroll
                for (int ks = 0; ks < 4; ++ks) {
                    const bf16x8 pb = __builtin_bit_cast(bf16x8, pw[ks]);
                    o0 = __builtin_amdgcn_mfma_f32_32x32x16_bf16(__builtin_bit_cast(bf16x8, vfa[ks]), pb, o0, 0, 0, 0);
                    o1 = __builtin_amdgcn_mfma_f32_32x32x16_bf16(__builtin_bit_cast(bf16x8, vfb[ks]), pb, o1, 0, 0, 0);
                }
            }
            if (js == nj - 1 && do_store) {
                const float l = l_run + __shfl_xor(l_run, 32); const float inv = 1.f / l;
                bf16_t* op = W.O + (long)qrow * W.rso + 4 * hi;
#pragma unroll
                for (int j = 0; j < 4; ++j) {
                    float a0 = o0[4 * j] * inv, a1 = o0[4 * j + 1] * inv, a2 = o0[4 * j + 2] * inv, a3 = o0[4 * j + 3] * inv;
                    float b0 = o1[4 * j] * inv, b1 = o1[4 * j + 1] * inv, b2 = o1[4 * j + 2] * inv, b3 = o1[4 * j + 3] * inv;
                    if (MLA) { const u32x2 za = *(const u32x2*)(op + 8 * j), zb = *(const u32x2*)(op + 32 + 8 * j);
                        a0 *= silu_f(bf_lo(za.x)); a1 *= silu_f(bf_hi(za.x)); a2 *= silu_f(bf_lo(za.y)); a3 *= silu_f(bf_hi(za.y));
                        b0 *= silu_f(bf_lo(zb.x)); b1 *= silu_f(bf_hi(zb.x)); b2 *= silu_f(bf_lo(zb.y)); b3 *= silu_f(bf_hi(zb.y)); }
                    *(u32x2*)(op + 8 * j) = (u32x2){cvt_pk_bf16(a0, a1), cvt_pk_bf16(a2, a3)};
                    *(u32x2*)(op + 32 + 8 * j) = (u32x2){cvt_pk_bf16(b0, b1), cvt_pk_bf16(b2, b3)};
                }
                if (!MLA) { if (hi == 0) W.lse[(long)qrow * W.rsl] = m_run + __builtin_amdgcn_logf(l); }
            }
        }
        if (s + 1 < ntot) ATT_WRITET((s + 1) & 1);
        __syncthreads();
    }
#undef ATT_LOADT
#undef ATT_WRITET
}


#define XB_TMO      128
#define XB_XCNT(j)  (256  + 64 * (j))
#define XB_XSUB(j)  (1280 + 64 * (j))
#define XB_XGEN(j)  (2304 + 64 * (j))
#define XB_TOP      3328
#define XB_TOPGEN   3392
#define XCD_BAR_WORDS 3456
#define XB_SPIN_CAP (1u << 18)
__device__ __forceinline__ unsigned xb_ld(unsigned* p)              { return __hip_atomic_load(p, __ATOMIC_RELAXED, __HIP_MEMORY_SCOPE_AGENT); }
__device__ __forceinline__ unsigned xb_add(unsigned* p, unsigned v) { return __hip_atomic_fetch_add(p, v, __ATOMIC_RELAXED, __HIP_MEMORY_SCOPE_AGENT); }
__device__ __forceinline__ unsigned xb_xcc_id() { return (unsigned)__builtin_amdgcn_s_getreg((3 << 11) | 20) & 0xFu; }
#define XB_SPIN(cond, bar) do { unsigned _sp = 0; while (cond) { __builtin_amdgcn_s_sleep(1); \
    if ((++_sp & 255u) == 0u) { if (xb_ld(&(bar)[XB_TMO])) break; if (_sp > XB_SPIN_CAP) { atomicAdd(&(bar)[XB_TMO], 1u); break; } } } } while (0)
struct XcdBarrier { unsigned* bar; unsigned x; volatile LAS unsigned* st; };
__device__ __forceinline__ XcdBarrier xcd_barrier_post(unsigned* bar, volatile LAS unsigned* st) {
    XcdBarrier b; b.bar = bar; b.x = xb_xcc_id(); b.st = st;
    if (threadIdx.x == 0) (void)xb_add(&bar[XB_XCNT(b.x)], 1u);
    return b;
}
__device__ __forceinline__ void xcd_barrier_complete(unsigned* bar, unsigned x, unsigned& nloc, unsigned& nx) {
    const unsigned G = gridDim.x * gridDim.y * gridDim.z;
    unsigned sum, cnt, mine, sp = 0u;
    for (;;) {
        sum = 0u; cnt = 0u; mine = 0u;
#pragma unroll
        for (unsigned j = 0; j < 16; ++j) { const unsigned c = xb_ld(&bar[XB_XCNT(j)]); sum += c; cnt += (c > 0u) ? 1u : 0u; mine = (j == x) ? c : mine; }
        if (sum == G) break;
        __builtin_amdgcn_s_sleep(1);
        if ((++sp & 255u) == 0u) { if (xb_ld(&bar[XB_TMO])) break; if (sp > XB_SPIN_CAP) { atomicAdd(&bar[XB_TMO], 1u); break; } }
    }
    nloc = mine > 0u ? mine : 1u; nx = cnt > 0u ? cnt : 1u;
}
__device__ __forceinline__ void xcd_barrier(const XcdBarrier& b) {
    asm volatile("s_waitcnt vmcnt(0)" ::: "memory");
    __syncthreads();
    if (threadIdx.x == 0) {
        unsigned* bar = b.bar;
        __builtin_amdgcn_s_waitcnt(0);
        unsigned nloc = b.st[0], nx = b.st[1];
        if (nloc == 0u) { xcd_barrier_complete(bar, b.x, nloc, nx); b.st[0] = nloc; b.st[1] = nx; }
        const unsigned old = xb_add(&bar[XB_XSUB(b.x)], 1u);
        const unsigned gen = old / nloc;
        if (old + 1u == (gen + 1u) * nloc) {
            __builtin_amdgcn_fence(__ATOMIC_RELEASE, "agent");
            asm volatile("s_waitcnt vmcnt(0)" ::: "memory");
            const unsigned og = xb_add(&bar[XB_TOP], 1u);
            const unsigned tg = og / nx;
            if (og + 1u == (tg + 1u) * nx) xb_add(&bar[XB_TOPGEN], 1u);
            else XB_SPIN(xb_ld(&bar[XB_TOPGEN]) == tg, bar);
            __builtin_amdgcn_fence(__ATOMIC_ACQUIRE, "agent");
            xb_add(&bar[XB_XGEN(b.x)], 1u);
            asm volatile("s_waitcnt vmcnt(0)" ::: "memory");
        } else {
            XB_SPIN(xb_ld(&bar[XB_XGEN(b.x)]) == gen, bar);
            __builtin_amdgcn_fence(__ATOMIC_ACQUIRE, "agent");
            asm volatile("s_waitcnt vmcnt(0)" ::: "memory");
        }
    }
    __syncthreads();
}

#ifndef REP_SYNC
#define REP_SYNC 1
#endif
#ifndef REP_P1
#define REP_P1 1
#endif
#ifndef REP_MLA
#define REP_MLA 1
#endif
#ifndef REP_DIL
#define REP_DIL 1
#endif
#ifndef REP_P4
#define REP_P4 1
#endif
#ifndef REP_P2
#define REP_P2 1
#endif
#ifndef P1_NOSTORE
#define P1_NOSTORE 0
#endif
#ifndef REP_PRO
#define REP_PRO 1
#endif
#ifndef REP_E3
#define REP_E3 1
#endif
#ifndef REP_CONV
#define REP_CONV 1
#endif
#ifndef REP_P5
#define REP_P5 1
#endif
struct Params { const float* in[18]; float* out; unsigned char* ws; int ph_lo, ph_hi; };
enum { I_X = 0, I_NORMG, I_WIN, I_BGATE, I_CONVW, I_CONVB, I_QAG, I_WUQ, I_KVAG, I_WUKV, I_MQG, I_MKG, I_DQG, I_DKG, I_WOA, I_WOB, I_WOC, I_WO };

__device__ __forceinline__ void transpose_item(const float* W, int ldw, int K, int src_col0, bf16_t* WT, int dst_row0, int k0, LAS float* scr, int lane, const float* ks = nullptr, int mixa_kb = -1) {
    if (src_col0 >= 0) {
        float wv[32], sv[32];
#pragma unroll
        for (int i = 0; i < 32; ++i) { const int kk = 2 * i + (lane >> 5); const int e_ = lane & 31; const int col_ = mixa_kb < 0 ? src_col0 + e_ : 512 * (mixa_kb + ((e_ >> 2) & 1)) + src_col0 + 4 * (e_ >> 3) + (e_ & 3); wv[i] = W[(size_t)(k0 + kk) * ldw + col_]; sv[i] = ks ? ks[k0 + kk] : 1.f; }
        __builtin_amdgcn_sched_barrier(0);
#pragma unroll
        for (int i = 0; i < 32; ++i) { const int kk = 2 * i + (lane >> 5); scr[kk * 33 + (lane & 31)] = wv[i] * sv[i]; }
    } else {
#pragma unroll 8
        for (int i = 0; i < 32; ++i) { const int kk = 2 * i + (lane >> 5); scr[kk * 33 + (lane & 31)] = 0.f; }
    }
    asm volatile("s_waitcnt lgkmcnt(0)" ::: "memory");
    const int c = lane & 7;
#pragma unroll
    for (int j = 0; j < 4; ++j) { const int n = (lane >> 3) + 8 * j; const LAS float* s = scr + (8 * c) * 33 + n;
        u32x4 o; o.x = cvt_pk_bf16(s[0 * 33], s[1 * 33]); o.y = cvt_pk_bf16(s[2 * 33], s[3 * 33]); o.z = cvt_pk_bf16(s[4 * 33], s[5 * 33]); o.w = cvt_pk_bf16(s[6 * 33], s[7 * 33]);
        *(u32x4*)(WT + (size_t)(dst_row0 + n) * K + k0 + 8 * c) = o; }
    asm volatile("s_waitcnt lgkmcnt(0)" ::: "memory");
}

__device__ __forceinline__ void convert_rows(const float* x, bf16_t* xb, int gw, int NGW, int lane) {
    for (int m0 = gw; m0 < TC; m0 += 4 * NGW) {
        f32x4 v[4][4];
#pragma unroll
        for (int r = 0; r < 4; ++r) { const int m = m0 + r * NGW; const f32x4* xr = (const f32x4*)(x + (size_t)(m < TC ? m : gw) * DM) + lane;
#pragma unroll
            for (int j = 0; j < 4; ++j) v[r][j] = xr[64 * j]; }
        __builtin_amdgcn_sched_barrier(0);
#pragma unroll
        for (int r = 0; r < 4; ++r) { const int m = m0 + r * NGW; float s = 0.f;
#pragma unroll
            for (int j = 0; j < 4; ++j) s += (v[r][j].x * v[r][j].x + v[r][j].y * v[r][j].y) + (v[r][j].z * v[r][j].z + v[r][j].w * v[r][j].w);
            const float rr = rsqrtf(wave_sum(s) * (1.f / DM) + EPS);
            if (m < TC) { u32x2* o = (u32x2*)(xb + (size_t)m * DM) + lane;
#pragma unroll
                for (int j = 0; j < 4; ++j) o[64 * j] = (u32x2){cvt_pk_bf16(v[r][j].x * rr, v[r][j].y * rr), cvt_pk_bf16(v[r][j].z * rr, v[r][j].w * rr)}; } }
    }
}
__device__ __forceinline__ void rescale_rows(const bf16_t* raw, bf16_t* xb, const float* ssx, int gw, int NGW, int lane) {
    for (int m0 = gw; m0 < TC; m0 += 4 * NGW) {
        u32x4 w[4][2]; float t[4];
#pragma unroll
        for (int r = 0; r < 4; ++r) { const int m = m0 + r * NGW, mc = m < TC ? m : gw; t[r] = lane < 16 ? ssx[(size_t)mc * 16 + lane] : 0.f;
            const u32x4* o = (const u32x4*)(raw + (size_t)mc * LDP) + lane; w[r][0] = o[0]; w[r][1] = o[64]; }
        __builtin_amdgcn_sched_barrier(0);
#pragma unroll
        for (int r = 0; r < 4; ++r) { const int m = m0 + r * NGW; const float rr = rsqrtf(wave_sum(t[r]) * (1.f / DM) + EPS);
            if (m < TC) { u32x4* o = (u32x4*)(xb + (size_t)m * DM) + lane;
#pragma unroll
                for (int j = 0; j < 2; ++j) { u32x4 y;
#pragma unroll
                    for (int e = 0; e < 4; ++e) y[e] = cvt_pk_bf16(bf_lo(w[r][j][e]) * rr, bf_hi(w[r][j][e]) * rr);
                    o[64 * j] = y; } } }
    }
}

__global__ void __launch_bounds__(512) mega(Params P) {
    extern __shared__ __attribute__((aligned(16))) unsigned char lds_raw[];
    LAS unsigned char* lds = (LAS unsigned char*)lds_raw;
    cg::grid_group grid = cg::this_grid();
    const int G = gridDim.x;
    unsigned char* ws = P.ws;
    float* ropet = (float*)(ws + OFF_ROPE);
    float* lsebuf = (float*)(ws + OFF_LSE);
    float* SS = (float*)(ws + OFF_SS); float* SSX = (float*)(ws + OFF_SSX);
    bf16_t* QB = (bf16_t*)(ws + OFF_QB); bf16_t* KB = (bf16_t*)(ws + OFF_KB); bf16_t* VB = (bf16_t*)(ws + OFF_VB);
    bf16_t* XB = (bf16_t*)(ws + OFF_XB); bf16_t* PROJ = (bf16_t*)(ws + OFF_PROJ);
    volatile LAS unsigned* bst = (volatile LAS unsigned*)(lds + 147456 - 16);
    if (threadIdx.x < 4) bst[threadIdx.x] = 0u;
    __syncthreads();
    const XcdBarrier xbar = xcd_barrier_post((unsigned*)(ws + OFF_BAR), bst);
    for (int ph = P.ph_lo; ph < P.ph_hi; ++ph) {
        if (ph > P.ph_lo) { for (int rs_ = 0; rs_ < REP_SYNC; ++rs_) { if (P.ph_hi > 100000) grid.sync(); else xcd_barrier(xbar); } }
        int tid = threadIdx.x; asm volatile("" : "+v"(tid));
        int bx = blockIdx.x; asm volatile("" : "+s"(bx));
        const int lane = tid & 63, wave = __builtin_amdgcn_readfirstlane(tid >> 6);
        const int gw = bx * 8 + wave, NGW = G * 8;
        if (ph == 0) {
            for (int rp_ = 0; rp_ < REP_PRO; ++rp_) {
            LAS float* scr = (LAS float*)(lds + wave * 16384);
            constexpr int IT_IN = (LDP / 32) * 16, IT_UQ = 24 * 4, IT_UKV = 32 * 2, IT_OUT = 32 * 8, IT_O = 32 * 16, IT_L = IT_IN + IT_UQ + IT_UKV + 3 * IT_OUT + IT_O;
            for (int it = gw; it < 2 * IT_L; it += NGW) {
                const int l = it / IT_L; int r = it % IT_L; unsigned char* wl = ws + (size_t)l * W_LAYER;
                if (r < IT_IN) { const int rg = r >> 4, kb = r & 15; const int p0 = 32 * rg, pn = p0 >> 8, within = p0 & 255, bj = within >> 7, wc = (within >> 5) & 3;
                    const int L = 256 * pn + 64 * wc + 32 * bj; const int src = L < 2464 ? L : (L < 2560 ? -1 : L - 96);
                    if (pn < 8) transpose_item(P.in[I_WIN] + (size_t)l * 1024 * 11168, 11168, 1024, 64 * pn + 16 * wc, (bf16_t*)(wl + W_IN), p0, 64 * kb, scr, lane, P.in[I_NORMG] + l * DM, 2 * bj);
                    else transpose_item(P.in[I_WIN] + (size_t)l * 1024 * 11168, 11168, 1024, src, (bf16_t*)(wl + W_IN), p0, 64 * kb, scr, lane, P.in[I_NORMG] + l * DM);
                    continue; }
                r -= IT_IN;
                if (r < IT_UQ) { transpose_item(P.in[I_WUQ] + (size_t)l * 256 * 768, 768, 256, 32 * (r >> 2), (bf16_t*)(wl + W_UQ), 32 * (r >> 2), 64 * (r & 3), scr, lane, P.in[I_QAG] + l * 256); continue; }
                r -= IT_UQ;
                if (r < IT_UKV) { const int rg = r >> 1, p0 = 32 * rg, pn = p0 >> 8, within = p0 & 255, bj = within >> 7, wc = (within >> 5) & 3, wu = 4 * pn + wc;
                    const int src = (wu < 8 ? 128 * wu : 128 * (wu - 8) + 64) + 32 * bj;
                    transpose_item(P.in[I_WUKV] + (size_t)l * 128 * 1024, 1024, 128, src, (bf16_t*)(wl + W_UKV), p0, 64 * (r & 1), scr, lane, P.in[I_KVAG] + l * 128); continue; }
                r -= IT_UKV;
                if (r < 3 * IT_OUT) { const int br = r / IT_OUT, q = r % IT_OUT; const float* src = P.in[I_WOA + br] + (size_t)l * 512 * 1024;
                    transpose_item(src, 1024, 512, 32 * (q >> 3), (bf16_t*)(wl + W_OA + (size_t)br * 1024 * 512 * 2), 32 * (q >> 3), 64 * (q & 7), scr, lane); continue; }
                r -= 3 * IT_OUT;
                transpose_item(P.in[I_WO] + (size_t)l * 1024 * 1024, 1024, 1024, 32 * (r >> 4), (bf16_t*)(wl + W_O), 32 * (r >> 4), 64 * (r & 15), scr, lane);
            }
            for (int i = bx * 512 + tid; i < 2048 * 16; i += G * 512) {
                const int pos = i >> 4, f = i & 15;
                const float inv = exp2f(-(float)f * (13.287712379549449f / 16.f));
                const float ang = (float)pos * inv;
                const double rev = (double)ang * 0.15915494309189535; const double fr = rev - rint(rev);
                const float a = (float)(fr * 6.283185307179586);
                ropet[2 * i] = cosf(a); ropet[2 * i + 1] = sinf(a);
            }
            convert_rows(P.in[I_X], XB, gw, NGW, lane);
            }
            continue;
        }
        const int id = ph - 1, kk13 = id % 11, chunk = id / 11, layer = kk13 >= 5 ? 1 : 0, k = layer == 0 ? kk13 : kk13 - 6;
        const size_t tok0 = (size_t)chunk * TC;
        const float* xin = (layer == 0 ? P.in[I_X] : P.out) + tok0 * DM;
        float* xout = P.out + tok0 * DM;
        unsigned char* wl = ws + (size_t)layer * W_LAYER;
        if (k < 0) {
            rescale_rows(PROJ + C_XRAW, XB, SSX, gw, NGW, lane);
        } else if (k == 0) {
            pg8::Gemm g{XB, (const bf16_t*)(wl + W_IN), TC, LDP, DM, DM, DM}; pg8::StaticOrder S; S.init(TC, LDP, G, bx);
            for (int rp_ = 0; rp_ < REP_P1; ++rp_) { pg8::EpiProj E{PROJ, P.in[I_DQG] + layer * 192, P.in[I_DKG] + layer * 192, SS, P1_NOSTORE ? rp_ == REP_P1 - 1 : true}; pg8::gemm_phase<pg8::EpiProj, pg8::StaticOrder>(lds, g, S, E, tid); asm volatile("" : "+v"(tid)); }
        } else if (k == 1) {
            for (int rp_ = 0; rp_ < REP_P2; ++rp_) {
            { int kk = 128; asm volatile("" : "+s"(kk)); pg8::Gemm g{PROJ + C_CKV, (const bf16_t*)(wl + W_UKV), TC, 1024, kk, LDP, 128}; pg8::StaticOrder S; S.init(TC, 1024, G, bx);
              pg8::EpiKV E{KB, VB, PROJ, SS, P.in[I_MKG] + layer * 96, ropet}; pg8::gemm_phase<pg8::EpiKV, pg8::StaticOrder>(lds, g, S, E, tid); }
            asm volatile("" : "+v"(tid)); asm volatile("" : "+s"(bx));
            { int kq = 256; asm volatile("" : "+s"(kq)); pg8::Gemm g{PROJ + C_CQ, (const bf16_t*)(wl + W_UQ), TC, 768, kq, LDP, 256}; pg8::StaticOrder S; S.init(TC, 768, G, G - 1 - bx);
              pg8::EpiPlain E{QB, 768}; pg8::gemm_phase<pg8::EpiPlain, pg8::StaticOrder>(lds, g, S, E, tid); }
            asm volatile("" : "+v"(tid)); }
            asm volatile("" : "+v"(tid)); asm volatile("" : "+s"(bx));
            const int hf = wave >> 2;
            for (int v = ((G & 7) == 0 ? (bx & 7) * (G >> 3) + (bx >> 3) : bx); v < 1536; v += G) {
                const int pp = v & 7, h = (v >> 3) & 7, gi = (v >> 6) % 3, b = v / 192;
                const int dil = gi == 0 ? 1 : (gi == 1 ? 4 : 16), nbc = 16 / dil;
                const int idx = 2 * pp + hf, r = idx / nbc, n = idx % nbc, n_other = (idx ^ 1) % nbc;
                const size_t row0 = (size_t)b * SEQ + r;
                HalfWork W;
                W.Q = PROJ + row0 * LDP + C_DQ + gi * 512 + 64 * h; W.K = PROJ + row0 * LDP + C_DK + gi * 512 + 64 * h; W.V = PROJ + row0 * LDP + C_DV + gi * 512 + 64 * h;
                W.O = const_cast<bf16_t*>(W.Q); W.lse = lsebuf + row0 * 24 + gi * 8 + h;
                W.rsq = W.rsk = W.rsv = W.rso = dil * LDP; W.rsl = dil * 24;
                const float slope = exp2f(-8.f * (float)(gi * 8 + h + 1) / 24.f);
                W.slope2 = slope * (float)dil * LOG2E; W.nback = 128;
                W.ssq = nullptr; W.gqn = nullptr; W.rope = nullptr;
                W.q0A = 128 * n; W.tloA = n > 0 ? 2 * n - 2 : 0; W.nA = 2 * n + 2 - W.tloA; W.q0B = 0; W.tloB = 0; W.nB = 0;
                const int n_oth = n_other > 0 ? 4 : 2;
                for (int rp_ = 0; rp_ < REP_DIL; ++rp_) attn_core<64, false>(lds, W, W.nA > n_oth ? W.nA : n_oth, tid, rp_ == REP_DIL - 1);
            }
            {
                const float* cw = P.in[I_CONVW] + layer * 3 * 512; const float* cb = P.in[I_CONVB] + layer * 512;
                for (int rp_ = 0; rp_ < REP_CONV; ++rp_)
                for (int it = bx * 512 + tid; it < (TC / 8) * 64; it += G * 512) {
                    const int cgp = it & 63, t0 = (it >> 6) * 8, c0 = 8 * cgp;
                    float w0[8], w1[8], w2[8], bb[8], u1[8], u2[8];
#pragma unroll
                    for (int e = 0; e < 8; ++e) { w0[e] = cw[c0 + e]; w1[e] = cw[512 + c0 + e]; w2[e] = cw[1024 + c0 + e]; bb[e] = cb[c0 + e]; u1[e] = 0.f; u2[e] = 0.f; }
                    if ((t0 & (SEQ - 1)) != 0) {
                        const u32x4 x1 = *(const u32x4*)(PROJ + (size_t)(t0 - 1) * LDP + C_AC + c0), x2 = *(const u32x4*)(PROJ + (size_t)(t0 - 2) * LDP + C_AC + c0);
#pragma unroll
                        for (int e = 0; e < 4; ++e) { u1[2 * e] = bf_lo(x1[e]); u1[2 * e + 1] = bf_hi(x1[e]); u2[2 * e] = bf_lo(x2[e]); u2[2 * e + 1] = bf_hi(x2[e]); }
                    }
                    u32x4 vg[8], vu[8];
#pragma unroll
                    for (int tt = 0; tt < 8; ++tt) { const bf16_t* rr = PROJ + (size_t)(t0 + tt) * LDP + c0; vg[tt] = *(const u32x4*)(rr + C_AB); vu[tt] = *(const u32x4*)(rr + C_AC); }
                    __builtin_amdgcn_sched_barrier(0);
#pragma unroll
                    for (int tt = 0; tt < 8; ++tt) {
                        bf16_t* rr = PROJ + (size_t)(t0 + tt) * LDP + c0; u32x4 y;
#pragma unroll
                        for (int e = 0; e < 4; ++e) {
                            const float ua = bf_lo(vu[tt][e]), ub = bf_hi(vu[tt][e]);
                            const float ca = bb[2 * e] + w0[2 * e] * u2[2 * e] + w1[2 * e] * u1[2 * e] + w2[2 * e] * ua;
                            const float cbv = bb[2 * e + 1] + w0[2 * e + 1] * u2[2 * e + 1] + w1[2 * e + 1] * u1[2 * e + 1] + w2[2 * e + 1] * ub;
                            u2[2 * e] = u1[2 * e]; u1[2 * e] = ua; u2[2 * e + 1] = u1[2 * e + 1]; u1[2 * e + 1] = ub;
                            y[e] = cvt_pk_bf16(bf_lo(vg[tt][e]) * ca, bf_hi(vg[tt][e]) * cbv); }
                        if (rp_ == REP_CONV - 1) *(u32x4*)(rr + C_AB) = y; else asm volatile("" :: "v"(y));
                    }
                }
            }
        } else if (k == 2) {
            const int hf = wave >> 2;
            for (int u = ((G & 7) == 0 ? (bx & 7) * (G >> 3) + (bx >> 3) : bx); u < 256; u += G) {
                const int b = u >> 5, hp = (u >> 3) & 3, p = u & 7, h = 2 * hp + hf;
                const int qbA = hf == 0 ? p : 15 - p, qbB = 15 - qbA;
                HalfWork W;
                W.Q = QB + (size_t)b * SEQ * 768 + 96 * h; W.K = KB + (size_t)b * SEQ * 768 + 96 * h; W.V = VB + (size_t)b * SEQ * 512 + 64 * h;
                W.O = PROJ + (size_t)b * SEQ * LDP + C_BZ + 64 * h; W.lse = nullptr;
                W.rsq = 768; W.rsk = 768; W.rsv = 512; W.rso = LDP; W.rsl = 0; W.slope2 = 0.f; W.nback = 1 << 28;
                W.ssq = SS + (size_t)b * SEQ * 8; W.gqn = P.in[I_MQG] + layer * 96; W.rope = ropet;
                W.q0A = 128 * qbA; W.tloA = 0; W.nA = 2 * qbA + 2; W.q0B = 128 * qbB; W.tloB = 0; W.nB = 2 * qbB + 2;
                for (int rp_ = 0; rp_ < REP_MLA; ++rp_) attn_core<96, true>(lds, W, 34, tid, rp_ == REP_MLA - 1);
            }
            for (int rp_ = 0; rp_ < REP_E3; ++rp_)
            for (int m0 = gw; m0 < TC; m0 += 4 * NGW) {
                const int h = lane >> 3, dc = lane & 7;
                u32x4 oa[4], ob[4], oc[4], zz[4]; float la[4], lb[4], lc[4];
#pragma unroll
                for (int r = 0; r < 4; ++r) { const int m = m0 + r * NGW, mc = m < TC ? m : gw; const bf16_t* row = PROJ + (size_t)mc * LDP; const float* ls = lsebuf + (size_t)mc * 24 + h;
                    la[r] = ls[0]; lb[r] = ls[8]; lc[r] = ls[16];
                    oa[r] = *(const u32x4*)(row + C_DQ + 64 * h + 8 * dc); ob[r] = *(const u32x4*)(row + C_DQ + 512 + 64 * h + 8 * dc); oc[r] = *(const u32x4*)(row + C_DQ + 1024 + 64 * h + 8 * dc);
                    zz[r] = *(const u32x4*)(row + C_CZ + 64 * h + 8 * dc); }
                __builtin_amdgcn_sched_barrier(0);
#pragma unroll
                for (int r = 0; r < 4; ++r) { const int m = m0 + r * NGW;
                    const float mx = fmaxf(la[r], fmaxf(lb[r], lc[r]));
                    float a0 = __builtin_amdgcn_exp2f(la[r] - mx), a1 = __builtin_amdgcn_exp2f(lb[r] - mx), a2 = __builtin_amdgcn_exp2f(lc[r] - mx); const float inv = __builtin_amdgcn_rcpf(a0 + a1 + a2); a0 *= inv; a1 *= inv; a2 *= inv;
                    u32x4 y;
#pragma unroll
                    for (int e = 0; e < 4; ++e) {
                        const float lo = (a0 * bf_lo(oa[r][e]) + a1 * bf_lo(ob[r][e]) + a2 * bf_lo(oc[r][e])) * silu_f(bf_lo(zz[r][e]));
                        const float hi = (a0 * bf_hi(oa[r][e]) + a1 * bf_hi(ob[r][e]) + a2 * bf_hi(oc[r][e])) * silu_f(bf_hi(zz[r][e]));
                        y[e] = cvt_pk_bf16(lo, hi); }
                    if (m < TC) { if (rp_ == REP_E3 - 1) *(u32x4*)(PROJ + (size_t)m * LDP + C_CZ + 64 * h + 8 * dc) = y; else asm volatile("" :: "v"(y)); } }
            }
        } else if (k == 3) {
            pg8::MergeOrder S; S.base.init(TC, DM, G, bx);
            for (int rp_ = 0; rp_ < REP_P4; ++rp_) {
            pg8::Gemm g{PROJ, (const bf16_t*)(wl + W_OA), TC, DM, 512, LDP, 512}; pg8::EpiMerge E{PROJ, P.in[I_BGATE] + layer * 3072};
            pg8::gemm_phase<pg8::EpiMerge, pg8::MergeOrder>(lds, g, S, E, tid); asm volatile("" : "+v"(tid)); }
        } else {
            pg8::Gemm g{PROJ + C_MB, (const bf16_t*)(wl + W_O), TC, DM, DM, LDP, DM}; pg8::StaticOrder S; S.init(TC, DM, G, bx);
            if (layer == 0) { pg8::EpiRes<false> E{xin, nullptr, nullptr, PROJ + C_XRAW, SSX}; pg8::gemm_phase<pg8::EpiRes<false>, pg8::StaticOrder>(lds, g, S, E, tid); }
            else { pg8::EpiRes<true> E{nullptr, PROJ + C_XRAW, xout, nullptr, nullptr}; pg8::gemm_phase<pg8::EpiRes<true>, pg8::StaticOrder>(lds, g, S, E, tid); }
            asm volatile("" : "+v"(tid));
            if (layer == 1 && chunk + 1 < NCH) convert_rows(P.in[I_X] + (tok0 + TC) * DM, XB, gw, NGW, lane);
        }
    }
}

constexpr int N_PHASES = 1 + NCH * 11;
constexpr int LDS_BYTES = 147456;

extern "C" void kernel_launch(void* const* d_in, const int* in_sizes, int n_in, void* d_out, int out_size, void* d_ws, size_t ws_size, hipStream_t stream) {
    static int grid = 0;
    if (grid == 0) {
        int dev = 0, cus = 0, per_cu = 0;
        hipGetDevice(&dev);
        hipDeviceGetAttribute(&cus, hipDeviceAttributeMultiprocessorCount, dev);
        hipFuncSetAttribute((const void*)mega, hipFuncAttributeMaxDynamicSharedMemorySize, LDS_BYTES);
        hipOccupancyMaxActiveBlocksPerMultiprocessor(&per_cu, (const void*)mega, 512, LDS_BYTES);
        (void)hipGetLastError();
        grid = cus;
        if (n_in != 18 || ws_size < WS_END || out_size != NB * SEQ * DM) { fprintf(stderr, "kernel_launch: unexpected shapes / workspace\n"); grid = -1; }
    }
    if (grid < 0) return;
    (void)hipMemsetAsync((unsigned char*)d_ws + OFF_BAR, 0, 16384, stream);
    Params p{};
    for (int i = 0; i < 18; ++i) p.in[i] = (const float*)d_in[i];
    p.out = (float*)d_out; p.ws = (unsigned char*)d_ws; p.ph_lo = 0; p.ph_hi = N_PHASES;
    void* args[] = {&p};
    hipError_t e = hipLaunchCooperativeKernel((const void*)mega, dim3(grid), dim3(512), args, LDS_BYTES, stream);
    if (e != hipSuccess) fprintf(stderr, "cooperative launch failed: %s\n", hipGetErrorString(e));
}
```

```cpp
#include <hip/hip_runtime.h>
#include <hip/hip_cooperative_groups.h>
#include <cstdio>
#include <cstdint>
namespace cg = cooperative_groups;

#define LAS __attribute__((address_space(3)))
typedef unsigned short bf16_t;
typedef short bf16x8 __attribute__((ext_vector_type(8)));
typedef float f32x4 __attribute__((ext_vector_type(4)));
typedef float f32x16 __attribute__((ext_vector_type(16)));
typedef unsigned u32x4 __attribute__((ext_vector_type(4)));
typedef unsigned u32x2 __attribute__((ext_vector_type(2)));

constexpr int DM = 1024, NB = 16, SEQ = 2048, CB = 8, TC = CB * SEQ, NCH = NB / CB;
constexpr int LDP = 11264;
constexpr int C_AB = 0, C_AC = 512, C_AX = 1024, C_AZ = 1536, C_CQ = 2048, C_CKV = 2304, C_KPE = 2432, C_BZ = 2560,
              C_DQ = 3072, C_DK = 4608, C_DV = 6144, C_CZ = 7680, C_GATE = 8192;
constexpr int C_XRAW = 1024;
constexpr int C_MB = C_DQ;
constexpr int C_MACC = C_DK;
constexpr float EPS = 1e-6f;
constexpr float LOG2E = 1.4426950408889634f;

constexpr size_t W_IN = 0, W_UQ = (size_t)LDP * 1024 * 2, W_UKV = W_UQ + 768 * 256 * 2, W_OA = W_UKV + 1024 * 128 * 2,
                 W_OB = W_OA + 1024 * 512 * 2, W_OC = W_OB + 1024 * 512 * 2, W_O = W_OC + 1024 * 512 * 2, W_LAYER = W_O + 1024 * 1024 * 2;
constexpr size_t OFF_ROPE = 2 * W_LAYER, OFF_LSE = OFF_ROPE + 2048 * 16 * 8, OFF_SS = OFF_LSE + (size_t)TC * 24 * 4, OFF_SSX = OFF_SS + (size_t)TC * 8 * 4, OFF_R = OFF_SSX + (size_t)TC * 16 * 4;
constexpr size_t OFF_QB = OFF_R, OFF_KB = OFF_QB + (size_t)TC * 768 * 2, OFF_VB = OFF_KB + (size_t)TC * 768 * 2;
constexpr size_t OFF_XB = OFF_R;
constexpr size_t OFF_PROJ = OFF_VB + (size_t)TC * 512 * 2, OFF_BAR = OFF_PROJ + (size_t)TC * LDP * 2, WS_END = OFF_BAR + 16384;
static_assert(OFF_R % 256 == 0 && WS_END <= 536870912ull, "ws map");

typedef float f32x2_t __attribute__((ext_vector_type(2))); typedef __bf16 bf16x2_t __attribute__((ext_vector_type(2)));
__device__ __forceinline__ unsigned cvt_pk_bf16(float lo, float hi) { f32x2_t v = {lo, hi}; bf16x2_t b = __builtin_convertvector(v, bf16x2_t); return __builtin_bit_cast(unsigned, b); }
__device__ __forceinline__ float bf_lo(unsigned w) { return __uint_as_float(w << 16); }
__device__ __forceinline__ float bf_hi(unsigned w) { return __uint_as_float(w & 0xffff0000u); }
__device__ __forceinline__ float wave_sum(float v) {
#pragma unroll
    for (int o = 1; o < 64; o <<= 1) v += __shfl_xor(v, o);
    return v;
}
__device__ __forceinline__ float silu_f(float z) { return z * __builtin_amdgcn_rcpf(1.f + __expf(-z)); }
__device__ __forceinline__ float sigm_f(float z) { return __builtin_amdgcn_rcpf(1.f + __expf(-z)); }

namespace pg8 {
constexpr int BM = 256, BK = 64, HALF = 128, HTB = HALF * BK * 2, STAGE_BYTES = 8 * HTB, NXCD = 8, WGM = 8;
__host__ __device__ __forceinline__ int lds_byte(int r, int c) { const int st = (r >> 4) * 2 + (c >> 5), rr = r & 15, cc = c & 31, ob = rr * 64 + cc * 2; return st * 1024 + (ob ^ (((ob >> 9) & 1) << 5)); }
__host__ __device__ __forceinline__ void stage_rc(int b, int& R, int& C) { const int st = b / 1024, sb = b % 1024, swz = sb ^ (((sb >> 9) & 1) << 5); R = (st >> 1) * 16 + swz / 64; C = (st & 1) * 32 + (swz % 64) / 2; }
__host__ __device__ __forceinline__ int perm32(int rho) { const int n = rho >> 4, i = rho & 15; return 8 * (i >> 2) + 4 * n + (i & 3); }
struct Unit { int pm, pn, br; };
struct Gemm { const bf16_t* A; const bf16_t* Bt; int M, N, K, lda, ldb; };
struct StaticOrder {
    int nM, nN, nwg, G, c;
    __device__ void init(int M, int N, int G_, int c_) { nM = M / BM; nN = N / BM; nwg = nM * nN; G = G_; c = c_; }
    __device__ bool next(int i, Unit& u) const {
        const long L = (long)i * G + c; if (L >= nwg) return false;
        int wgid = (int)L; { const int q = nwg / NXCD, r = nwg % NXCD, xcd = wgid % NXCD, off = wgid / NXCD; wgid = (xcd < r ? xcd * (q + 1) : r * (q + 1) + (xcd - r) * q) + off; }
        const int nig = WGM * nN, gid = wgid / nig, fm = gid * WGM, gsz = (nM - fm) < WGM ? (nM - fm) : WGM;
        u.pm = fm + ((wgid % nig) % gsz); u.pn = (wgid % nig) / gsz; u.br = 0; return true;
    }
    __device__ __forceinline__ size_t aoff(const Unit&) const { return 0; }
    __device__ __forceinline__ size_t boff(const Unit&) const { return 0; }
};
struct MergeOrder {
    StaticOrder base;
    __device__ bool next(int i, Unit& u) const { const int ti = i / 3; if (!base.next(ti, u)) return false; u.br = i - 3 * ti; return true; }
    __device__ __forceinline__ size_t aoff(const Unit& u) const { return (size_t)(u.br == 0 ? C_AB : (u.br == 1 ? C_BZ : C_CZ)) * 2; }
    __device__ __forceinline__ size_t boff(const Unit& u) const { return (size_t)u.br * (1024 * 512 * 2); }
};

template <class Epi, class Sched, bool ALIGN_EPI = true, bool SP2 = true>
__device__ __forceinline__ void gemm_phase(LAS unsigned char* lds, const Gemm g, const Sched& S, const Epi& E, const int tid) {
    const int wid = __builtin_amdgcn_readfirstlane(tid >> 6), lane = tid & 63, wr = wid >> 2, wc = wid & 3, fr = lane & 15, fq = lane >> 4;
    const int K = g.K, nt = K / BK;
    unsigned voffA[2], voffB[2];
#pragma unroll
    for (int i = 0; i < 2; ++i) { int R, C; stage_rc(tid * 16 + i * 8192, R, C); const int Rb = (R & ~31) + perm32(R & 31);
        voffA[i] = (unsigned)(R * g.lda + C) * 2u; voffB[i] = (unsigned)(Rb * g.ldb + C) * 2u; }
    const size_t kstep = (size_t)(BK * 2);
    const size_t hstepA = (size_t)HALF * g.lda * 2, hstepB = (size_t)HALF * g.ldb * 2;
    const size_t tstepA = 2 * hstepA, tstepB = 2 * hstepB;
    const unsigned ldsw = (unsigned)wid * 1024u;
    const int aoff = lds_byte(wr * 64 + fr, fq * 8), boff = lds_byte(wc * 32 + fr, fq * 8);
#define PG8_SA(b, h) (((b) * 2 + (h)) * HTB)
#define PG8_SB(b, h) ((4 + (b) * 2 + (h)) * HTB)
#define PG8_STAGE(bufoff, gbase, voff) do { _Pragma("unroll") for (int _i = 0; _i < 2; ++_i) \
        __builtin_amdgcn_global_load_lds((const unsigned*)((const char*)(gbase) + (voff)[_i]), (LAS unsigned*)(lds + (bufoff) + ldsw + _i * 8192), 16, 0, 0); } while (0)
#define PG8_LDA(dst, b, h) do { _Pragma("unroll") for (int m = 0; m < 4; ++m) _Pragma("unroll") for (int k = 0; k < 2; ++k) dst[m][k] = *(const LAS bf16x8*)(lds + PG8_SA(b, h) + aoff + m * 2048 + k * 1024); } while (0)
#define PG8_LDB(dst, b, h) do { _Pragma("unroll") for (int n = 0; n < 2; ++n) _Pragma("unroll") for (int k = 0; k < 2; ++k) dst[n][k] = *(const LAS bf16x8*)(lds + PG8_SB(b, h) + boff + n * 2048 + k * 1024); } while (0)
#define PG8_MMA(ai, bj, At, Bt) do { __builtin_amdgcn_s_setprio(1); _Pragma("unroll") for (int m = 0; m < 4; ++m) _Pragma("unroll") for (int n = 0; n < 2; ++n) _Pragma("unroll") for (int k = 0; k < 2; ++k) \
        acc[ai][bj][m][n] = __builtin_amdgcn_mfma_f32_16x16x32_bf16(Bt[n][k], At[m][k], acc[ai][bj][m][n], 0, 0, 0); __builtin_amdgcn_s_setprio(0); } while (0)
#define PG8_WAIT_V(n) asm volatile("s_waitcnt vmcnt(" #n ")" ::: "memory")
#define PG8_WAIT_L(n) asm volatile("s_waitcnt lgkmcnt(" #n ")" ::: "memory")
#define PG8_BAR __builtin_amdgcn_s_barrier()
#define PG8_SCHED __builtin_amdgcn_sched_barrier(0)
    Unit cur, nxt; int ui = 0;
    if (!S.next(0, cur)) return;
    f32x4 acc[2][2][4][2];
#pragma unroll
    for (int a = 0; a < 2; ++a)
#pragma unroll
        for (int b = 0; b < 2; ++b)
#pragma unroll
            for (int m = 0; m < 4; ++m)
#pragma unroll
                for (int n = 0; n < 2; ++n) acc[a][b][m][n] = (f32x4){0.f, 0.f, 0.f, 0.f};
    bf16x8 At[4][2], B0[2][2], B1[2][2];
    const char* cA = (const char*)g.A + (size_t)cur.pm * tstepA + S.aoff(cur); const char* cB = (const char*)g.Bt + (size_t)cur.pn * tstepB + S.boff(cur);
    static_assert(SP2, "only the SP2 loop is kept");
    PG8_STAGE(PG8_SB(0, 0), cB, voffB); PG8_STAGE(PG8_SB(0, 1), cB + hstepB, voffB); PG8_STAGE(PG8_SA(0, 0), cA, voffA); PG8_STAGE(PG8_SA(0, 1), cA + hstepA, voffA);
    if (wr == 1) PG8_BAR;
    PG8_WAIT_V(2); PG8_BAR;
    PG8_STAGE(PG8_SB(1, 0), cB + kstep, voffB); PG8_STAGE(PG8_SA(1, 0), cA + kstep, voffA); PG8_STAGE(PG8_SB(1, 1), cB + hstepB + kstep, voffB);
    PG8_WAIT_V(6); PG8_BAR;
    for (;;) {
        const bool has_next = S.next(ui + 1, nxt);
        const char* nA = has_next ? (const char*)g.A + (size_t)nxt.pm * tstepA + S.aoff(nxt) : cA; const char* nB = has_next ? (const char*)g.Bt + (size_t)nxt.pn * tstepB + S.boff(nxt) : cB;
#pragma nounroll
        for (int t = 0; t < nt; t += 2) {
            const bool last = (t == nt - 2);
            const char* a1 = cA + (size_t)(t + 1) * kstep;
            const char* a2 = last ? nA : cA + (size_t)(t + 2) * kstep; const char* b2 = last ? nB : cB + (size_t)(t + 2) * kstep;
            const char* a3 = a2 + kstep; const char* b3 = b2 + kstep;
            PG8_LDB(B0, 0, 0); PG8_LDB(B1, 0, 1); PG8_SCHED; PG8_LDA(At, 0, 0); PG8_STAGE(PG8_SA(1, 1), a1 + hstepA, voffA);
            PG8_WAIT_V(8); PG8_WAIT_L(0); PG8_BAR; PG8_MMA(0, 0, At, B0); PG8_MMA(0, 1, At, B1); PG8_BAR; PG8_SCHED;
            PG8_LDA(At, 0, 1); PG8_STAGE(PG8_SB(0, 0), b2, voffB); PG8_STAGE(PG8_SB(0, 1), b2 + hstepB, voffB); PG8_STAGE(PG8_SA(0, 0), a2, voffA);
            PG8_WAIT_V(8); PG8_WAIT_L(0); PG8_BAR; PG8_MMA(1, 0, At, B0); PG8_MMA(1, 1, At, B1); PG8_BAR; PG8_SCHED;
            PG8_LDB(B0, 1, 0); PG8_LDB(B1, 1, 1); PG8_SCHED; PG8_LDA(At, 1, 0); PG8_STAGE(PG8_SA(0, 1), a2 + hstepA, voffA);
            PG8_WAIT_V(8); PG8_WAIT_L(0); PG8_BAR; PG8_MMA(0, 0, At, B0); PG8_MMA(0, 1, At, B1); PG8_BAR; PG8_SCHED;
            PG8_LDA(At, 1, 1); PG8_STAGE(PG8_SB(1, 0), b3, voffB); PG8_STAGE(PG8_SB(1, 1), b3 + hstepB, voffB); PG8_STAGE(PG8_SA(1, 0), a3, voffA);
            PG8_WAIT_V(8); PG8_WAIT_L(0); PG8_BAR; PG8_MMA(1, 0, At, B0); PG8_MMA(1, 1, At, B1); PG8_BAR; PG8_SCHED;
        }
        if constexpr (ALIGN_EPI) { if (wr == 0) PG8_BAR; }
        E(acc, cur, wr, wc, fr, fq);
        if (!has_next) break;
#pragma unroll
        for (int a = 0; a < 2; ++a)
#pragma unroll
            for (int b = 0; b < 2; ++b)
#pragma unroll
                for (int m = 0; m < 4; ++m)
#pragma unroll
                    for (int n = 0; n < 2; ++n) acc[a][b][m][n] = (f32x4){0.f, 0.f, 0.f, 0.f};
        cur = nxt; cA = nA; cB = nB; ++ui;
        if constexpr (ALIGN_EPI) { if (wr == 1) PG8_BAR; }
    }
    PG8_WAIT_V(0);
    if constexpr (!ALIGN_EPI) { if (wr == 0) PG8_BAR; }
    PG8_BAR;
#undef PG8_SA
#undef PG8_SB
#undef PG8_STAGE
#undef PG8_LDA
#undef PG8_LDB
#undef PG8_MMA
#undef PG8_WAIT_V
#undef PG8_WAIT_L
#undef PG8_BAR
#undef PG8_SCHED
}

struct EpiPlain {
    bf16_t* O; int ldc;
    __device__ __forceinline__ void operator()(const f32x4 (&acc)[2][2][4][2], const Unit& u, int wr, int wc, int fr, int fq) const {
        const int row0 = u.pm * BM + wr * 64 + fr, col0 = u.pn * BM + wc * 32 + 8 * fq;
#pragma unroll
        for (int ai = 0; ai < 2; ++ai)
#pragma unroll
            for (int m = 0; m < 4; ++m) { bf16_t* rowp = O + (size_t)(row0 + ai * HALF + m * 16) * ldc + col0;
#pragma unroll
                for (int bj = 0; bj < 2; ++bj) { const f32x4 v0 = acc[ai][bj][m][0], v1 = acc[ai][bj][m][1]; u32x4 w;
                    w.x = cvt_pk_bf16(v0[0], v0[1]); w.y = cvt_pk_bf16(v0[2], v0[3]); w.z = cvt_pk_bf16(v1[0], v1[1]); w.w = cvt_pk_bf16(v1[2], v1[3]);
                    *(u32x4*)(rowp + bj * HALF) = w; } }
    }
};
struct EpiProj {
    bf16_t* O; const float* gq; const float* gk;
    float* ss; bool st;
    const float* bgate;
    __device__ __forceinline__ void operator()(const f32x4 (&acc)[2][2][4][2], const Unit& u, int wr, int wc, int fr, int fq) const {
        const int row0 = u.pm * BM + wr * 64 + fr, col0 = u.pn * BM + wc * 64 + 8 * fq;
        if (u.pn < 8) {
            const int ch0 = 64 * u.pn + 16 * wc + 4 * fq;
#pragma unroll
            for (int ai = 0; ai < 2; ++ai)
#pragma unroll
                for (int m = 0; m < 4; ++m) { const int row = u.pm * BM + wr * 64 + fr + ai * HALF + m * 16;
                    const f32x4 ab = acc[ai][0][m][0], ac = acc[ai][0][m][1], ax = acc[ai][1][m][0], az = acc[ai][1][m][1];
                    f32x4 gz, uu = ac * ax;
#pragma unroll
                    for (int i = 0; i < 4; ++i) gz[i] = ab[i] * silu_f(az[i]);
                    bf16_t* rowp = O + (size_t)row * LDP + ch0;
                    if (st) { *(u32x2*)(rowp + C_AB) = (u32x2){cvt_pk_bf16(gz[0], gz[1]), cvt_pk_bf16(gz[2], gz[3])}; *(u32x2*)(rowp + C_AC) = (u32x2){cvt_pk_bf16(uu[0], uu[1]), cvt_pk_bf16(uu[2], uu[3])}; }
                    else asm volatile("" :: "v"(gz), "v"(uu)); }
            return;
        }
        if (u.pn >= 32) {
            const int g0c = (u.pn - 32) * BM + wc * 64 + 8 * fq;
            f32x4 bv[2][2];
#pragma unroll
            for (int bj = 0; bj < 2; ++bj)
#pragma unroll
                for (int n = 0; n < 2; ++n) bv[bj][n] = *(const f32x4*)(bgate + g0c + bj * 32 + n * 4);
#pragma unroll
            for (int ai = 0; ai < 2; ++ai)
#pragma unroll
                for (int m = 0; m < 4; ++m) { const int row = u.pm * BM + wr * 64 + fr + ai * HALF + m * 16;
                    unsigned char* gb = (unsigned char*)(O + (size_t)row * LDP + C_GATE) + g0c;
#pragma unroll
                    for (int bj = 0; bj < 2; ++bj) { u32x2 w;
#pragma unroll
                        for (int n = 0; n < 2; ++n) { const f32x4 x = acc[ai][bj][m][n] + bv[bj][n]; unsigned pk = 0u;
#pragma unroll
                            for (int i = 0; i < 4; ++i) pk |= ((unsigned)(sigm_f(x[i]) * 255.f + 0.5f)) << (8 * i);
                            w[n] = pk; }
                        if (st) *(u32x2*)(gb + bj * 32) = w; else asm volatile("" :: "v"(w)); } }
            return;
        }
        const bool nrm = (u.pn >= 12 && u.pn < 24);
        const bool stat = (u.pn == 8) || (u.pn == 9 && wc < 3);
        f32x4 gv[2][2];
        if (nrm) { const bool isq = u.pn < 18; const int gi = ((u.pn - 12) % 6) >> 1; const float* gp = (isq ? gq : gk) + gi * 64 + 8 * fq; const float post = isq ? 0.125f * LOG2E : 1.f;
#pragma unroll
            for (int bj = 0; bj < 2; ++bj)
#pragma unroll
                for (int n = 0; n < 2; ++n) gv[bj][n] = *(const f32x4*)(gp + bj * 32 + n * 4) * post;
        } else {
#pragma unroll
            for (int bj = 0; bj < 2; ++bj)
#pragma unroll
                for (int n = 0; n < 2; ++n) gv[bj][n] = (f32x4){1.f, 1.f, 1.f, 1.f};
        }
#pragma unroll
        for (int ai = 0; ai < 2; ++ai)
#pragma unroll
            for (int m = 0; m < 4; ++m) {
                const int row = row0 + ai * HALF + m * 16;
                f32x4 v[2][2];
#pragma unroll
                for (int bj = 0; bj < 2; ++bj)
#pragma unroll
                    for (int n = 0; n < 2; ++n) v[bj][n] = acc[ai][bj][m][n];
                float r = 1.f;
                if (nrm || stat) { float ss_ = 0.f;
#pragma unroll
                    for (int bj = 0; bj < 2; ++bj)
#pragma unroll
                        for (int n = 0; n < 2; ++n) { const f32x4 x = v[bj][n]; ss_ += (x[0] * x[0] + x[1] * x[1]) + (x[2] * x[2] + x[3] * x[3]); }
                    ss_ += __shfl_xor(ss_, 16); ss_ += __shfl_xor(ss_, 32);
                    if (nrm) r = rsqrtf(ss_ * (1.f / 64.f) + EPS);
                    else if (fq == 0) ss[(size_t)row * 8 + (u.pn == 8 ? wc : 4 + wc)] = ss_; }
                bf16_t* rowp = O + (size_t)row * LDP + col0;
#pragma unroll
                for (int bj = 0; bj < 2; ++bj) { const f32x4 v0 = v[bj][0] * r * gv[bj][0], v1 = v[bj][1] * r * gv[bj][1]; u32x4 w;
                    w.x = cvt_pk_bf16(v0[0], v0[1]); w.y = cvt_pk_bf16(v0[2], v0[3]); w.z = cvt_pk_bf16(v1[0], v1[1]); w.w = cvt_pk_bf16(v1[2], v1[3]);
                    if (st) *(u32x4*)(rowp + bj * 32) = w; else asm volatile("" :: "v"(w)); } }
    }
};
struct EpiKV {
    bf16_t* KBo; bf16_t* VBo; const bf16_t* proj; const float* ss; const float* gk; const float* rope;
    __device__ __forceinline__ void operator()(const f32x4 (&acc)[2][2][4][2], const Unit& u, int wr, int wc, int fr, int fq) const {
        const int row0 = u.pm * BM + wr * 64 + fr; const int wu = 4 * u.pn + wc;
        if (wu < 8) {
            f32x4 gv[2][2];
#pragma unroll
            for (int bj = 0; bj < 2; ++bj)
#pragma unroll
                for (int n = 0; n < 2; ++n) gv[bj][n] = *(const f32x4*)(gk + bj * 32 + 8 * fq + n * 4);
            const f32x4 g1 = *(const f32x4*)(gk + 64 + 4 * fq), g2 = *(const f32x4*)(gk + 80 + 4 * fq);
#pragma unroll
            for (int ai = 0; ai < 2; ++ai) {
                f32x4 s4h[4];
#pragma unroll
                for (int m = 0; m < 4; ++m) s4h[m] = *(const f32x4*)(ss + (size_t)(row0 + ai * HALF + m * 16) * 8 + 4);
                __builtin_amdgcn_sched_barrier(0);
#pragma unroll
                for (int m = 0; m < 4; ++m) {
                    const int row = row0 + ai * HALF + m * 16;
                    const f32x4 s4 = s4h[m];
                    const float rkv = rsqrtf((s4.x + s4.y) * (1.f / 128.f) + EPS);
                    f32x4 v[2][2]; float q = 0.f;
#pragma unroll
                    for (int bj = 0; bj < 2; ++bj)
#pragma unroll
                        for (int n = 0; n < 2; ++n) { v[bj][n] = acc[ai][bj][m][n] * rkv; const f32x4 x = v[bj][n]; q += (x[0] * x[0] + x[1] * x[1]) + (x[2] * x[2] + x[3] * x[3]); }
                    q += __shfl_xor(q, 16); q += __shfl_xor(q, 32);
                    const float rk = rsqrtf((q + s4.z) * (1.f / 96.f) + EPS);
                    bf16_t* kr = KBo + (size_t)row * 768 + 96 * wu;
#pragma unroll
                    for (int bj = 0; bj < 2; ++bj) { const f32x4 v0 = v[bj][0] * rk * gv[bj][0], v1 = v[bj][1] * rk * gv[bj][1]; u32x4 w;
                        w.x = cvt_pk_bf16(v0[0], v0[1]); w.y = cvt_pk_bf16(v0[2], v0[3]); w.z = cvt_pk_bf16(v1[0], v1[1]); w.w = cvt_pk_bf16(v1[2], v1[3]);
                        *(u32x4*)(kr + bj * 32 + 8 * fq) = w; }
                    const bf16_t* pe = proj + (size_t)row * LDP + C_KPE;
                    const u32x2 a = *(const u32x2*)(pe + 4 * fq), b = *(const u32x2*)(pe + 16 + 4 * fq);
                    const int pos = row & (SEQ - 1);
                    const f32x4 cs0 = *(const f32x4*)(rope + (size_t)(pos * 16 + 4 * fq) * 2), cs1 = *(const f32x4*)(rope + (size_t)(pos * 16 + 4 * fq) * 2 + 4);
                    const f32x4 t1 = (f32x4){bf_lo(a.x), bf_hi(a.x), bf_lo(a.y), bf_hi(a.y)} * g1 * rk, t2 = (f32x4){bf_lo(b.x), bf_hi(b.x), bf_lo(b.y), bf_hi(b.y)} * g2 * rk;
                    const f32x4 cc = (f32x4){cs0.x, cs0.z, cs1.x, cs1.z}, sn = (f32x4){cs0.y, cs0.w, cs1.y, cs1.w};
                    const f32x4 o1 = t1 * cc - t2 * sn, o2 = t2 * cc + t1 * sn;
                    *(u32x2*)(kr + 64 + 4 * fq) = (u32x2){cvt_pk_bf16(o1[0], o1[1]), cvt_pk_bf16(o1[2], o1[3])};
                    *(u32x2*)(kr + 80 + 4 * fq) = (u32x2){cvt_pk_bf16(o2[0], o2[1]), cvt_pk_bf16(o2[2], o2[3])};
                }
            }
        } else {
            typedef float f32x2v __attribute__((ext_vector_type(2)));
            f32x2v s2v[2][4];
#pragma unroll
            for (int ai = 0; ai < 2; ++ai)
#pragma unroll
                for (int m = 0; m < 4; ++m) s2v[ai][m] = *(const f32x2v*)(ss + (size_t)(row0 + ai * HALF + m * 16) * 8 + 4);
            __builtin_amdgcn_sched_barrier(0);
#pragma unroll
            for (int ai = 0; ai < 2; ++ai)
#pragma unroll
                for (int m = 0; m < 4; ++m) {
                    const int row = row0 + ai * HALF + m * 16;
                    const float rkv = rsqrtf((s2v[ai][m].x + s2v[ai][m].y) * (1.f / 128.f) + EPS);
                    bf16_t* vr = VBo + (size_t)row * 512 + 64 * (wu - 8);
#pragma unroll
                    for (int bj = 0; bj < 2; ++bj) { const f32x4 v0 = acc[ai][bj][m][0] * rkv, v1 = acc[ai][bj][m][1] * rkv; u32x4 w;
                        w.x = cvt_pk_bf16(v0[0], v0[1]); w.y = cvt_pk_bf16(v0[2], v0[3]); w.z = cvt_pk_bf16(v1[0], v1[1]); w.w = cvt_pk_bf16(v1[2], v1[3]);
                        *(u32x4*)(vr + bj * 32 + 8 * fq) = w; } }
        }
    }
};
struct EpiMerge {
    const bf16_t* proj; const float* bgate;
    __device__ __forceinline__ void operator()(const f32x4 (&acc)[2][2][4][2], const Unit& u, int wr, int wc, int fr, int fq) const {
        const int row0 = u.pm * BM + wr * 64 + fr, col0 = u.pn * BM + wc * 32 + 8 * fq; const int BR = u.br;
        const bool first = BR == 0, last = BR == 2;
        const int dcol = last ? C_MB : C_MACC;
        u32x2 gS[2][2]; u32x4 pS[2][2];
#define MG_LOAD(R, SET) do { const size_t rb_ = (size_t)(row0 + ((R) >> 2) * HALF + ((R) & 3) * 16) * LDP; \
            _Pragma("unroll") for (int bj_ = 0; bj_ < 2; ++bj_) { const int c_ = col0 + bj_ * HALF; \
                gS[SET][bj_] = *(const u32x2*)((const unsigned char*)(proj + rb_ + C_GATE) + BR * 1024 + c_); pS[SET][bj_] = *(const u32x4*)(proj + rb_ + C_MACC + c_); } } while (0)
        MG_LOAD(0, 0);
#pragma unroll
        for (int r = 0; r < 8; ++r) {
            const int ai = r >> 2, m = r & 3;
            if (r + 1 < 8) { if ((r & 1) == 0) MG_LOAD(r + 1, 1); else MG_LOAD(r + 1, 0); }
            __builtin_amdgcn_sched_barrier(0);
#pragma unroll
            for (int bj = 0; bj < 2; ++bj) { const size_t rb = (size_t)(row0 + ai * HALF + m * 16) * LDP; const int c = col0 + bj * HALF;
                const u32x2 g = gS[r & 1][bj]; const u32x4 p = pS[r & 1][bj];
                f32x4 g0, g1;
#pragma unroll
                for (int i = 0; i < 4; ++i) { g0[i] = (float)((g.x >> (8 * i)) & 255u) * (1.f / 255.f); g1[i] = (float)((g.y >> (8 * i)) & 255u) * (1.f / 255.f); }
                f32x4 v0 = acc[ai][bj][m][0] * g0, v1 = acc[ai][bj][m][1] * g1;
                const f32x4 p0 = (f32x4){bf_lo(p.x), bf_hi(p.x), bf_lo(p.y), bf_hi(p.y)}, p1 = (f32x4){bf_lo(p.z), bf_hi(p.z), bf_lo(p.w), bf_hi(p.w)};
#pragma unroll
                for (int i = 0; i < 4; ++i) { v0[i] += first ? 0.f : p0[i]; v1[i] += first ? 0.f : p1[i]; }
                u32x4 w; w.x = cvt_pk_bf16(v0[0], v0[1]); w.y = cvt_pk_bf16(v0[2], v0[3]); w.z = cvt_pk_bf16(v1[0], v1[1]); w.w = cvt_pk_bf16(v1[2], v1[3]);
                *(u32x4*)(const_cast<bf16_t*>(proj) + rb + dcol + c) = w; }
            __builtin_amdgcn_sched_barrier(0);
        }
#undef MG_LOAD
    }
};
template <bool BF_IN> struct EpiRes {
    const float* xin; const bf16_t* xinb; float* out; bf16_t* xb; float* ssx;
    __device__ __forceinline__ void operator()(const f32x4 (&acc)[2][2][4][2], const Unit& u, int wr, int wc, int fr, int fq) const {
        const int row0 = u.pm * BM + wr * 64 + fr, col0 = u.pn * BM + wc * 32 + 8 * fq;
#pragma unroll
        for (int aq = 0; aq < 4; ++aq) { const int ai = aq >> 1, m0 = (aq & 1) * 2;
            f32x4 xa[2][2], xc[2][2];
#pragma unroll
            for (int mm = 0; mm < 2; ++mm)
#pragma unroll
                for (int bj = 0; bj < 2; ++bj) { const int row = row0 + ai * HALF + (m0 + mm) * 16;
                    if (BF_IN) { const u32x4 w = *(const u32x4*)(xinb + (size_t)row * LDP + col0 + bj * HALF);
                        xa[mm][bj] = (f32x4){bf_lo(w.x), bf_hi(w.x), bf_lo(w.y), bf_hi(w.y)}; xc[mm][bj] = (f32x4){bf_lo(w.z), bf_hi(w.z), bf_lo(w.w), bf_hi(w.w)}; }
                    else { const size_t off = (size_t)row * DM + col0 + bj * HALF; xa[mm][bj] = *(const f32x4*)(xin + off); xc[mm][bj] = *(const f32x4*)(xin + off + 4); } }
            __builtin_amdgcn_sched_barrier(0);
#pragma unroll
            for (int mm = 0; mm < 2; ++mm) { const int m = m0 + mm; const int row = row0 + ai * HALF + m * 16; const size_t off = (size_t)row * DM + col0; float q = 0.f;
#pragma unroll
                for (int bj = 0; bj < 2; ++bj) { const f32x4 a = xa[mm][bj] + acc[ai][bj][m][0], b = xc[mm][bj] + acc[ai][bj][m][1];
                    if (BF_IN) { *(f32x4*)(out + off + bj * HALF) = a; *(f32x4*)(out + off + bj * HALF + 4) = b; }
                    else { q += (a[0] * a[0] + a[1] * a[1]) + (a[2] * a[2] + a[3] * a[3]) + (b[0] * b[0] + b[1] * b[1]) + (b[2] * b[2] + b[3] * b[3]);
                        u32x4 w; w.x = cvt_pk_bf16(a[0], a[1]); w.y = cvt_pk_bf16(a[2], a[3]); w.z = cvt_pk_bf16(b[0], b[1]); w.w = cvt_pk_bf16(b[2], b[3]);
                        *(u32x4*)(xb + (size_t)row * LDP + col0 + bj * HALF) = w; } }
                if (!BF_IN) { q += __shfl_xor(q, 16); q += __shfl_xor(q, 32); if (fq == 0) ssx[(size_t)row * 16 + 4 * u.pn + wc] = q; } }
            __builtin_amdgcn_sched_barrier(0);
        }
    }
};
}

struct HalfWork {
    const bf16_t *Q, *K, *V; bf16_t* O; float* lse;
    int rsq, rsk, rsv, rso, rsl;
    float slope2; int nback;
    const float *ssq, *gqn, *rope;
    int q0A, tloA, nA, q0B, tloB, nB;
};
template <int DK, bool MLA>
__device__ __forceinline__ void attn_core(LAS unsigned char* lds, const HalfWork& W, const int NS, const int tid, const bool do_store = true) {
    const int lane = tid & 63, r32 = lane & 31, hi = lane >> 5;
    const int wid = __builtin_amdgcn_readfirstlane(tid >> 6), hf = wid >> 2, w4 = wid & 3, ht = tid & 255;
    constexpr int KSTR = DK * 2 + 16, VSTR = 136, KBYTES = 64 * KSTR, BUFB = KBYTES + 64 * VSTR;
    constexpr int KP = DK / 8, KPT = (64 * KP) / 256;
    LAS unsigned char* hb = lds + hf * (2 * BUFB);
    u32x4 kreg[KPT], vreg[2];
    bf16x8 qf[DK / 16];
    float m_run = -INFINITY, l_run = 0.f; f32x16 o0 = {}, o1 = {};
    const int ntot = W.nA + W.nB;
#define ATT_LOADT(s) do { const bool a_ = (s) < W.nA; const int t_ = a_ ? (W.tloA + (s)) : (W.tloB + (s) - W.nA); \
        const bf16_t* kp_ = W.K + (long)(64 * t_) * W.rsk; const bf16_t* vp_ = W.V + (long)(64 * t_) * W.rsv; \
        _Pragma("unroll") for (int i_ = 0; i_ < KPT; ++i_) { const int idx_ = ht + 256 * i_, row_ = idx_ / KP, ch_ = idx_ % KP; kreg[i_] = *(const u32x4*)(kp_ + (long)row_ * W.rsk + ch_ * 8); } \
        _Pragma("unroll") for (int i_ = 0; i_ < 2; ++i_) { const int idx_ = ht + 256 * i_, row_ = idx_ >> 3, ch_ = idx_ & 7; vreg[i_] = *(const u32x4*)(vp_ + (long)row_ * W.rsv + ch_ * 8); } } while (0)
#define ATT_WRITET(buf) do { LAS unsigned char* kb_ = hb + (buf) * BUFB; \
        _Pragma("unroll") for (int i_ = 0; i_ < KPT; ++i_) { const int idx_ = ht + 256 * i_, row_ = idx_ / KP, ch_ = idx_ % KP; *(LAS u32x4*)(kb_ + row_ * KSTR + ch_ * 16) = kreg[i_]; } \
        _Pragma("unroll") for (int i_ = 0; i_ < 2; ++i_) { const int idx_ = ht + 256 * i_, row_ = idx_ >> 3, ch_ = idx_ & 7; \
            _Pragma("unroll") for (int e_ = 0; e_ < 8; ++e_) { const unsigned w_ = vreg[i_][e_ >> 1]; \
                *(LAS unsigned short*)(kb_ + KBYTES + (8 * ch_ + e_) * VSTR + row_ * 2) = (unsigned short)((e_ & 1) ? (w_ >> 16) : (w_ & 0xffffu)); } } } while (0)
    if (ntot > 0) { ATT_LOADT(0); ATT_WRITET(0); }
    __syncthreads();
    for (int s = 0; s < NS; ++s) {
        if (s + 1 < ntot) ATT_LOADT(s + 1);
        if (s < ntot) {
            const bool inA = s < W.nA; const int js = inA ? s : s - W.nA;
            const int q0 = inA ? W.q0A : W.q0B; const int t = (inA ? W.tloA : W.tloB) + js; const int nj = inA ? W.nA : W.nB;
            const int qrow = q0 + w4 * 32 + r32;
            if (js == 0) {
                const bf16_t* qp = W.Q + (long)qrow * W.rsq + hi * 8;
#pragma unroll
                for (int ds = 0; ds < DK / 16; ++ds) qf[ds] = *(const bf16x8*)(qp + ds * 16);
                m_run = -INFINITY; l_run = 0.f; o0 = (f32x16){}; o1 = (f32x16){};
                if (MLA) {
                    float qv[DK / 16][8]; float ssl = 0.f;
#pragma unroll
                    for (int ds = 0; ds < DK / 16; ++ds) { const u32x4 w = __builtin_bit_cast(u32x4, qf[ds]);
#pragma unroll
                        for (int e = 0; e < 4; ++e) { qv[ds][2 * e] = bf_lo(w[e]); qv[ds][2 * e + 1] = bf_hi(w[e]); ssl += qv[ds][2 * e] * qv[ds][2 * e] + qv[ds][2 * e + 1] * qv[ds][2 * e + 1]; } }
                    ssl += __shfl_xor(ssl, 32);
                    const f32x4 s4 = *(const f32x4*)(W.ssq + (size_t)qrow * 8);
                    const float rq = rsqrtf(((s4.x + s4.y) + (s4.z + s4.w)) * (1.f / 256.f) + EPS);
                    const float rn = rsqrtf(ssl * rq * rq * (1.f / 96.f) + EPS) * rq * (0.10206207261596575f * LOG2E);
#pragma unroll
                    for (int ds = 0; ds < DK / 16; ++ds) { const f32x4 ga = *(const f32x4*)(W.gqn + 16 * ds + 8 * hi), gb = *(const f32x4*)(W.gqn + 16 * ds + 8 * hi + 4);
#pragma unroll
                        for (int e = 0; e < 4; ++e) { qv[ds][e] *= rn * ga[e]; qv[ds][4 + e] *= rn * gb[e]; } }
                    const float* rp = W.rope + (size_t)(qrow * 16 + 8 * hi) * 2;
#pragma unroll
                    for (int e2 = 0; e2 < 4; ++e2) { const f32x4 cs = *(const f32x4*)(rp + 4 * e2);
                        { const float t1 = qv[DK / 16 - 2][2 * e2], t2 = qv[DK / 16 - 1][2 * e2]; qv[DK / 16 - 2][2 * e2] = t1 * cs.x - t2 * cs.y; qv[DK / 16 - 1][2 * e2] = t2 * cs.x + t1 * cs.y; }
                        { const float t1 = qv[DK / 16 - 2][2 * e2 + 1], t2 = qv[DK / 16 - 1][2 * e2 + 1]; qv[DK / 16 - 2][2 * e2 + 1] = t1 * cs.z - t2 * cs.w; qv[DK / 16 - 1][2 * e2 + 1] = t2 * cs.z + t1 * cs.w; } }
#pragma unroll
                    for (int ds = 0; ds < DK / 16; ++ds) { u32x4 w;
#pragma unroll
                        for (int e = 0; e < 4; ++e) w[e] = cvt_pk_bf16(qv[ds][2 * e], qv[ds][2 * e + 1]);
                        qf[ds] = __builtin_bit_cast(bf16x8, w); }
                }
            }
            const int qs = q0 + w4 * 32;
            const bool useful = (64 * t <= qs + 31) && (64 * t + 63 >= qs - W.nback);
            if (useful) {
                LAS const unsigned char* Kl = hb + (s & 1) * BUFB; LAS const unsigned char* Vl = Kl + KBYTES;
                f32x16 p0 = {}, p1 = {};
                bf16x8 kfa[DK / 16], kfb[DK / 16];
#pragma unroll
                for (int ds = 0; ds < DK / 16; ++ds) {
                    kfa[ds] = *(LAS const bf16x8*)(Kl + r32 * KSTR + ds * 32 + hi * 16);
                    kfb[ds] = *(LAS const bf16x8*)(Kl + (32 + r32) * KSTR + ds * 32 + hi * 16);
                }
                __builtin_amdgcn_sched_barrier(0);
#pragma unroll
                for (int ds = 0; ds < DK / 16; ++ds) {
                    p0 = __builtin_amdgcn_mfma_f32_32x32x16_bf16(kfa[ds], qf[ds], p0, 0, 0, 0);
                    p1 = __builtin_amdgcn_mfma_f32_32x32x16_bf16(kfb[ds], qf[ds], p1, 0, 0, 0);
                }
                u32x4 vfa[4], vfb[4];
#pragma unroll
                for (int ks = 0; ks < 4; ++ks) {
                    { LAS const unsigned char* va = Vl + r32 * VSTR + (16 * ks + 4 * hi) * 2; const u32x2 lo = *(LAS const u32x2*)va, hh = *(LAS const u32x2*)(va + 16); vfa[ks] = (u32x4){lo.x, lo.y, hh.x, hh.y}; }
                    { LAS const unsigned char* va = Vl + (32 + r32) * VSTR + (16 * ks + 4 * hi) * 2; const u32x2 lo = *(LAS const u32x2*)va, hh = *(LAS const u32x2*)(va + 16); vfb[ks] = (u32x4){lo.x, lo.y, hh.x, hh.y}; }
                }
                __builtin_amdgcn_sched_barrier(0);
                const bool full = MLA && (64 * t + 63 <= qs);
                if (!full) {
                    const int kb = 64 * t + 4 * hi;
#pragma unroll
                    for (int r = 0; r < 16; ++r) { const int d0 = qrow - (kb + (r & 3) + 8 * (r >> 2)), d1 = d0 - 32;
                        p0[r] = (d0 >= 0 && d0 <= W.nback) ? (MLA ? p0[r] : p0[r] - W.slope2 * (float)d0) : -INFINITY;
                        p1[r] = (d1 >= 0 && d1 <= W.nback) ? (MLA ? p1[r] : p1[r] - W.slope2 * (float)d1) : -INFINITY; }
                }
                float mx = fmaxf(p0[0], p1[0]);
#pragma unroll
                for (int r = 1; r < 16; ++r) mx = fmaxf(mx, fmaxf(p0[r], p1[r]));
                mx = fmaxf(mx, __shfl_xor(mx, 32));
                const float mnew = fmaxf(m_run, mx);
                const float muse = (mnew == -INFINITY) ? 0.f : mnew;
                const float alpha = __builtin_amdgcn_exp2f(m_run - muse);
                m_run = mnew;
                float rs = 0.f;
#pragma unroll
                for (int r = 0; r < 16; ++r) { p0[r] = __builtin_amdgcn_exp2f(p0[r] - muse); p1[r] = __builtin_amdgcn_exp2f(p1[r] - muse); rs += p0[r] + p1[r]; }
                l_run = l_run * alpha + rs;
#pragma unroll
                for (int r = 0; r < 16; ++r) { o0[r] *= alpha; o1[r] *= alpha; }
                u32x4 pw[4];
#pragma unroll
                for (int e = 0; e < 4; ++e) { pw[0][e] = cvt_pk_bf16(p0[2 * e], p0[2 * e + 1]); pw[1][e] = cvt_pk_bf16(p0[8 + 2 * e], p0[9 + 2 * e]);
                    pw[2][e] = cvt_pk_bf16(p1[2 * e], p1[2 * e + 1]); pw[3][e] = cvt_pk_bf16(p1[8 + 2 * e], p1[9 + 2 * e]); }
#pragma unroll
                for (int ks = 0; ks < 4; ++ks) {
                    const bf16x8 pb = __builtin_bit_cast(bf16x8, pw[ks]);
                    o0 = __builtin_amdgcn_mfma_f32_32x32x16_bf16(__builtin_bit_cast(bf16x8, vfa[ks]), pb, o0, 0, 0, 0);
                    o1 = __builtin_amdgcn_mfma_f32_32x32x16_bf16(__builtin_bit_cast(bf16x8, vfb[ks]), pb, o1, 0, 0, 0);
                }
            }
            if (js == nj - 1 && do_store) {
                const float l = l_run + __shfl_xor(l_run, 32); const float inv = 1.f / l;
                bf16_t* op = W.O + (long)qrow * W.rso + 4 * hi;
#pragma unroll
                for (int j = 0; j < 4; ++j) {
                    float a0 = o0[4 * j] * inv, a1 = o0[4 * j + 1] * inv, a2 = o0[4 * j + 2] * inv, a3 = o0[4 * j + 3] * inv;
                    float b0 = o1[4 * j] * inv, b1 = o1[4 * j + 1] * inv, b2 = o1[4 * j + 2] * inv, b3 = o1[4 * j + 3] * inv;
                    if (MLA) { const u32x2 za = *(const u32x2*)(op + 8 * j), zb = *(const u32x2*)(op + 32 + 8 * j);
                        a0 *= silu_f(bf_lo(za.x)); a1 *= silu_f(bf_hi(za.x)); a2 *= silu_f(bf_lo(za.y)); a3 *= silu_f(bf_hi(za.y));
                        b0 *= silu_f(bf_lo(zb.x)); b1 *= silu_f(bf_hi(zb.x)); b2 *= silu_f(bf_lo(zb.y)); b3 *= silu_f(bf_hi(zb.y)); }
                    *(u32x2*)(op + 8 * j) = (u32x2){cvt_pk_bf16(a0, a1), cvt_pk_bf16(a2, a3)};
                    *(u32x2*)(op + 32 + 8 * j) = (u32x2){cvt_pk_bf16(b0, b1), cvt_pk_bf16(b2, b3)};
                }
                if (!MLA) { if (hi == 0) W.lse[(long)qrow * W.rsl] = m_run + __builtin_amdgcn_logf(l); }
            }
        }
        if (s + 1 < ntot) ATT_WRITET((s + 1) & 1);
        __syncthreads();
    }
#undef ATT_LOADT
#undef ATT_WRITET
}


#define XB_TMO      128
#define XB_XCNT(j)  (256  + 64 * (j))
#define XB_XSUB(j)  (1280 + 64 * (j))
#define XB_XGEN(j)  (2304 + 64 * (j))
#define XB_TOP      3328
#define XB_TOPGEN   3392
#define XCD_BAR_WORDS 3456
#define XB_SPIN_CAP (1u << 18)
__device__ __forceinline__ unsigned xb_ld(unsigned* p)              { return __hip_atomic_load(p, __ATOMIC_RELAXED, __HIP_MEMORY_SCOPE_AGENT); }
__device__ __forceinline__ unsigned xb_add(unsigned* p, unsigned v) { return __hip_atomic_fetch_add(p, v, __ATOMIC_RELAXED, __HIP_MEMORY_SCOPE_AGENT); }
__device__ __forceinline__ unsigned xb_xcc_id() { return (unsigned)__builtin_amdgcn_s_getreg((3 << 11) | 20) & 0xFu; }
#define XB_SPIN(cond, bar) do { unsigned _sp = 0; while (cond) { __builtin_amdgcn_s_sleep(1); \
    if ((++_sp & 255u) == 0u) { if (xb_ld(&(bar)[XB_TMO])) break; if (_sp > XB_SPIN_CAP) { atomicAdd(&(bar)[XB_TMO], 1u); break; } } } } while (0)
struct XcdBarrier { unsigned* bar; unsigned x; volatile LAS unsigned* st; };
__device__ __forceinline__ XcdBarrier xcd_barrier_post(unsigned* bar, volatile LAS unsigned* st) {
    XcdBarrier b; b.bar = bar; b.x = xb_xcc_id(); b.st = st;
    if (threadIdx.x == 0) (void)xb_add(&bar[XB_XCNT(b.x)], 1u);
    return b;
}
__device__ __forceinline__ void xcd_barrier_complete(unsigned* bar, unsigned x, unsigned& nloc, unsigned& nx) {
    const unsigned G = gridDim.x * gridDim.y * gridDim.z;
    unsigned sum, cnt, mine, sp = 0u;
    for (;;) {
        sum = 0u; cnt = 0u; mine = 0u;
#pragma unroll
        for (unsigned j = 0; j < 16; ++j) { const unsigned c = xb_ld(&bar[XB_XCNT(j)]); sum += c; cnt += (c > 0u) ? 1u : 0u; mine = (j == x) ? c : mine; }
        if (sum == G) break;
        __builtin_amdgcn_s_sleep(1);
        if ((++sp & 255u) == 0u) { if (xb_ld(&bar[XB_TMO])) break; if (sp > XB_SPIN_CAP) { atomicAdd(&bar[XB_TMO], 1u); break; } }
    }
    nloc = mine > 0u ? mine : 1u; nx = cnt > 0u ? cnt : 1u;
}
__device__ __forceinline__ void xcd_barrier(const XcdBarrier& b) {
    asm volatile("s_waitcnt vmcnt(0)" ::: "memory");
    __syncthreads();
    if (threadIdx.x == 0) {
        unsigned* bar = b.bar;
        __builtin_amdgcn_s_waitcnt(0);
        unsigned nloc = b.st[0], nx = b.st[1];
        if (nloc == 0u) { xcd_barrier_complete(bar, b.x, nloc, nx); b.st[0] = nloc; b.st[1] = nx; }
        const unsigned old = xb_add(&bar[XB_XSUB(b.x)], 1u);
        const unsigned gen = old / nloc;
        if (old + 1u == (gen + 1u) * nloc) {
            __builtin_amdgcn_fence(__ATOMIC_RELEASE, "agent");
            asm volatile("s_waitcnt vmcnt(0)" ::: "memory");
            const unsigned og = xb_add(&bar[XB_TOP], 1u);
            const unsigned tg = og / nx;
            if (og + 1u == (tg + 1u) * nx) xb_add(&bar[XB_TOPGEN], 1u);
            else XB_SPIN(xb_ld(&bar[XB_TOPGEN]) == tg, bar);
            __builtin_amdgcn_fence(__ATOMIC_ACQUIRE, "agent");
            xb_add(&bar[XB_XGEN(b.x)], 1u);
            asm volatile("s_waitcnt vmcnt(0)" ::: "memory");
        } else {
            XB_SPIN(xb_ld(&bar[XB_XGEN(b.x)]) == gen, bar);
            __builtin_amdgcn_fence(__ATOMIC_ACQUIRE, "agent");
            asm volatile("s_waitcnt vmcnt(0)" ::: "memory");
        }
    }
    __syncthreads();
}

#ifndef REP_SYNC
#define REP_SYNC 1
#endif
#ifndef REP_P1
#define REP_P1 1
#endif
#ifndef REP_MLA
#define REP_MLA 1
#endif
#ifndef REP_DIL
#define REP_DIL 1
#endif
#ifndef REP_P4
#define REP_P4 1
#endif
#ifndef REP_P2
#define REP_P2 1
#endif
#ifndef P1_NOSTORE
#define P1_NOSTORE 0
#endif
#ifndef REP_PRO
#define REP_PRO 1
#endif
#ifndef REP_E3
#define REP_E3 1
#endif
#ifndef REP_CONV
#define REP_CONV 1
#endif
#ifndef REP_P5
#define REP_P5 1
#endif
struct Params { const float* in[18]; float* out; unsigned char* ws; int ph_lo, ph_hi; };
enum { I_X = 0, I_NORMG, I_WIN, I_BGATE, I_CONVW, I_CONVB, I_QAG, I_WUQ, I_KVAG, I_WUKV, I_MQG, I_MKG, I_DQG, I_DKG, I_WOA, I_WOB, I_WOC, I_WO };

__device__ __forceinline__ void transpose_item(const float* W, int ldw, int K, int src_col0, bf16_t* WT, int dst_row0, int k0, LAS float* scr, int lane, const float* ks = nullptr, int mixa_kb = -1) {
    if (src_col0 >= 0) {
        float wv[32], sv[32];
#pragma unroll
        for (int i = 0; i < 32; ++i) { const int kk = 2 * i + (lane >> 5); const int e_ = lane & 31; const int col_ = mixa_kb < 0 ? src_col0 + e_ : 512 * (mixa_kb + ((e_ >> 2) & 1)) + src_col0 + 4 * (e_ >> 3) + (e_ & 3); wv[i] = W[(size_t)(k0 + kk) * ldw + col_]; sv[i] = ks ? ks[k0 + kk] : 1.f; }
        __builtin_amdgcn_sched_barrier(0);
#pragma unroll
        for (int i = 0; i < 32; ++i) { const int kk = 2 * i + (lane >> 5); scr[kk * 33 + (lane & 31)] = wv[i] * sv[i]; }
    } else {
#pragma unroll 8
        for (int i = 0; i < 32; ++i) { const int kk = 2 * i + (lane >> 5); scr[kk * 33 + (lane & 31)] = 0.f; }
    }
    asm volatile("s_waitcnt lgkmcnt(0)" ::: "memory");
    const int c = lane & 7;
#pragma unroll
    for (int j = 0; j < 4; ++j) { const int n = (lane >> 3) + 8 * j; const LAS float* s = scr + (8 * c) * 33 + n;
        u32x4 o; o.x = cvt_pk_bf16(s[0 * 33], s[1 * 33]); o.y = cvt_pk_bf16(s[2 * 33], s[3 * 33]); o.z = cvt_pk_bf16(s[4 * 33], s[5 * 33]); o.w = cvt_pk_bf16(s[6 * 33], s[7 * 33]);
        *(u32x4*)(WT + (size_t)(dst_row0 + n) * K + k0 + 8 * c) = o; }
    asm volatile("s_waitcnt lgkmcnt(0)" ::: "memory");
}

__device__ __forceinline__ void convert_rows(const float* x, bf16_t* xb, int gw, int NGW, int lane) {
    for (int m0 = gw; m0 < TC; m0 += 4 * NGW) {
        f32x4 v[4][4];
#pragma unroll
        for (int r = 0; r < 4; ++r) { const int m = m0 + r * NGW; const f32x4* xr = (const f32x4*)(x + (size_t)(m < TC ? m : gw) * DM) + lane;
#pragma unroll
            for (int j = 0; j < 4; ++j) v[r][j] = xr[64 * j]; }
        __builtin_amdgcn_sched_barrier(0);
#pragma unroll
        for (int r = 0; r < 4; ++r) { const int m = m0 + r * NGW; float s = 0.f;
#pragma unroll
            for (int j = 0; j < 4; ++j) s += (v[r][j].x * v[r][j].x + v[r][j].y * v[r][j].y) + (v[r][j].z * v[r][j].z + v[r][j].w * v[r][j].w);
            const float rr = rsqrtf(wave_sum(s) * (1.f / DM) + EPS);
            if (m < TC) { u32x2* o = (u32x2*)(xb + (size_t)m * DM) + lane;
#pragma unroll
                for (int j = 0; j < 4; ++j) o[64 * j] = (u32x2){cvt_pk_bf16(v[r][j].x * rr, v[r][j].y * rr), cvt_pk_bf16(v[r][j].z * rr, v[r][j].w * rr)}; } }
    }
}
__device__ __forceinline__ void rescale_rows(const bf16_t* raw, bf16_t* xb, const float* ssx, int gw, int NGW, int lane) {
    for (int m0 = gw; m0 < TC; m0 += 4 * NGW) {
        u32x4 w[4][2]; float t[4];
#pragma unroll
        for (int r = 0; r < 4; ++r) { const int m = m0 + r * NGW, mc = m < TC ? m : gw; t[r] = lane < 16 ? ssx[(size_t)mc * 16 + lane] : 0.f;
            const u32x4* o = (const u32x4*)(raw + (size_t)mc * LDP) + lane; w[r][0] = o[0]; w[r][1] = o[64]; }
        __builtin_amdgcn_sched_barrier(0);
#pragma unroll
        for (int r = 0; r < 4; ++r) { const int m = m0 + r * NGW; const float rr = rsqrtf(wave_sum(t[r]) * (1.f / DM) + EPS);
            if (m < TC) { u32x4* o = (u32x4*)(xb + (size_t)m * DM) + lane;
#pragma unroll
                for (int j = 0; j < 2; ++j) { u32x4 y;
#pragma unroll
                    for (int e = 0; e < 4; ++e) y[e] = cvt_pk_bf16(bf_lo(w[r][j][e]) * rr, bf_hi(w[r][j][e]) * rr);
                    o[64 * j] = y; } } }
    }
}

__global__ void __launch_bounds__(512) mega(Params P) {
    extern __shared__ __attribute__((aligned(16))) unsigned char lds_raw[];
    LAS unsigned char* lds = (LAS unsigned char*)lds_raw;
    cg::grid_group grid = cg::this_grid();
    const int G = gridDim.x;
    unsigned char* ws = P.ws;
    float* ropet = (float*)(ws + OFF_ROPE);
    float* lsebuf = (float*)(ws + OFF_LSE);
    float* SS = (float*)(ws + OFF_SS); float* SSX = (float*)(ws + OFF_SSX);
    bf16_t* QB = (bf16_t*)(ws + OFF_QB); bf16_t* KB = (bf16_t*)(ws + OFF_KB); bf16_t* VB = (bf16_t*)(ws + OFF_VB);
    bf16_t* XB = (bf16_t*)(ws + OFF_XB); bf16_t* PROJ = (bf16_t*)(ws + OFF_PROJ);
    volatile LAS unsigned* bst = (volatile LAS unsigned*)(lds + 147456 - 16);
    if (threadIdx.x < 4) bst[threadIdx.x] = 0u;
    __syncthreads();
    const XcdBarrier xbar = xcd_barrier_post((unsigned*)(ws + OFF_BAR), bst);
    for (int ph = P.ph_lo; ph < P.ph_hi; ++ph) {
        if (ph > P.ph_lo) { for (int rs_ = 0; rs_ < REP_SYNC; ++rs_) { if (P.ph_hi > 100000) grid.sync(); else xcd_barrier(xbar); } }
        int tid = threadIdx.x; asm volatile("" : "+v"(tid));
        int bx = blockIdx.x; asm volatile("" : "+s"(bx));
        const int lane = tid & 63, wave = __builtin_amdgcn_readfirstlane(tid >> 6);
        const int gw = bx * 8 + wave, NGW = G * 8;
        if (ph == 0) {
            for (int rp_ = 0; rp_ < REP_PRO; ++rp_) {
            LAS float* scr = (LAS float*)(lds + wave * 16384);
            constexpr int IT_IN = (LDP / 32) * 16, IT_UQ = 24 * 4, IT_UKV = 32 * 2, IT_OUT = 32 * 8, IT_O = 32 * 16, IT_L = IT_IN + IT_UQ + IT_UKV + 3 * IT_OUT + IT_O;
            for (int it = gw; it < 2 * IT_L; it += NGW) {
                const int l = it / IT_L; int r = it % IT_L; unsigned char* wl = ws + (size_t)l * W_LAYER;
                if (r < IT_IN) { const int rg = r >> 4, kb = r & 15; const int p0 = 32 * rg, pn = p0 >> 8, within = p0 & 255, bj = within >> 7, wc = (within >> 5) & 3;
                    const int L = 256 * pn + 64 * wc + 32 * bj; const int src = L < 2464 ? L : (L < 2560 ? -1 : L - 96);
                    if (pn < 8) transpose_item(P.in[I_WIN] + (size_t)l * 1024 * 11168, 11168, 1024, 64 * pn + 16 * wc, (bf16_t*)(wl + W_IN), p0, 64 * kb, scr, lane, P.in[I_NORMG] + l * DM, 2 * bj);
                    else transpose_item(P.in[I_WIN] + (size_t)l * 1024 * 11168, 11168, 1024, src, (bf16_t*)(wl + W_IN), p0, 64 * kb, scr, lane, P.in[I_NORMG] + l * DM);
                    continue; }
                r -= IT_IN;
                if (r < IT_UQ) { transpose_item(P.in[I_WUQ] + (size_t)l * 256 * 768, 768, 256, 32 * (r >> 2), (bf16_t*)(wl + W_UQ), 32 * (r >> 2), 64 * (r & 3), scr, lane, P.in[I_QAG] + l * 256); continue; }
                r -= IT_UQ;
                if (r < IT_UKV) { const int rg = r >> 1, p0 = 32 * rg, pn = p0 >> 8, within = p0 & 255, bj = within >> 7, wc = (within >> 5) & 3, wu = 4 * pn + wc;
                    const int src = (wu < 8 ? 128 * wu : 128 * (wu - 8) + 64) + 32 * bj;
                    transpose_item(P.in[I_WUKV] + (size_t)l * 128 * 1024, 1024, 128, src, (bf16_t*)(wl + W_UKV), p0, 64 * (r & 1), scr, lane, P.in[I_KVAG] + l * 128); continue; }
                r -= IT_UKV;
                if (r < 3 * IT_OUT) { const int br = r / IT_OUT, q = r % IT_OUT; const float* src = P.in[I_WOA + br] + (size_t)l * 512 * 1024;
                    transpose_item(src, 1024, 512, 32 * (q >> 3), (bf16_t*)(wl + W_OA + (size_t)br * 1024 * 512 * 2), 32 * (q >> 3), 64 * (q & 7), scr, lane); continue; }
                r -= 3 * IT_OUT;
                transpose_item(P.in[I_WO] + (size_t)l * 1024 * 1024, 1024, 1024, 32 * (r >> 4), (bf16_t*)(wl + W_O), 32 * (r >> 4), 64 * (r & 15), scr, lane);
            }
            for (int i = bx * 512 + tid; i < 2048 * 16; i += G * 512) {
                const int pos = i >> 4, f = i & 15;
                const float inv = exp2f(-(float)f * (13.287712379549449f / 16.f));
                const float ang = (float)pos * inv;
                const double rev = (double)ang * 0.15915494309189535; const double fr = rev - rint(rev);
                const float a = (float)(fr * 6.283185307179586);
                ropet[2 * i] = cosf(a); ropet[2 * i + 1] = sinf(a);
            }
            convert_rows(P.in[I_X], XB, gw, NGW, lane);
            }
            continue;
        }
        const int id = ph - 1, kk13 = id % 11, chunk = id / 11, layer = kk13 >= 5 ? 1 : 0, k = layer == 0 ? kk13 : kk13 - 6;
        const size_t tok0 = (size_t)chunk * TC;
        const float* xin = (layer == 0 ? P.in[I_X] : P.out) + tok0 * DM;
        float* xout = P.out + tok0 * DM;
        unsigned char* wl = ws + (size_t)layer * W_LAYER;
        if (k < 0) {
            rescale_rows(PROJ + C_XRAW, XB, SSX, gw, NGW, lane);
        } else if (k == 0) {
            pg8::Gemm g{XB, (const bf16_t*)(wl + W_IN), TC, LDP, DM, DM, DM}; pg8::StaticOrder S; S.init(TC, LDP, G, bx);
            for (int rp_ = 0; rp_ < REP_P1; ++rp_) { pg8::EpiProj E{PROJ, P.in[I_DQG] + layer * 192, P.in[I_DKG] + layer * 192, SS, P1_NOSTORE ? rp_ == REP_P1 - 1 : true, P.in[I_BGATE] + layer * 3072}; pg8::gemm_phase<pg8::EpiProj, pg8::StaticOrder>(lds, g, S, E, tid); asm volatile("" : "+v"(tid)); }
        } else if (k == 1) {
            for (int rp_ = 0; rp_ < REP_P2; ++rp_) {
            { int kk = 128; asm volatile("" : "+s"(kk)); pg8::Gemm g{PROJ + C_CKV, (const bf16_t*)(wl + W_UKV), TC, 1024, kk, LDP, 128}; pg8::StaticOrder S; S.init(TC, 1024, G, bx);
              pg8::EpiKV E{KB, VB, PROJ, SS, P.in[I_MKG] + layer * 96, ropet}; pg8::gemm_phase<pg8::EpiKV, pg8::StaticOrder>(lds, g, S, E, tid); }
            asm volatile("" : "+v"(tid)); asm volatile("" : "+s"(bx));
            { int kq = 256; asm volatile("" : "+s"(kq)); pg8::Gemm g{PROJ + C_CQ, (const bf16_t*)(wl + W_UQ), TC, 768, kq, LDP, 256}; pg8::StaticOrder S; S.init(TC, 768, G, G - 1 - bx);
              pg8::EpiPlain E{QB, 768}; pg8::gemm_phase<pg8::EpiPlain, pg8::StaticOrder>(lds, g, S, E, tid); }
            asm volatile("" : "+v"(tid)); }
            asm volatile("" : "+v"(tid)); asm volatile("" : "+s"(bx));
            const int hf = wave >> 2;
            for (int v = ((G & 7) == 0 ? (bx & 7) * (G >> 3) + (bx >> 3) : bx); v < 1536; v += G) {
                const int pp = v & 7, h = (v >> 3) & 7, gi = (v >> 6) % 3, b = v / 192;
                const int dil = gi == 0 ? 1 : (gi == 1 ? 4 : 16), nbc = 16 / dil;
                const int idx = 2 * pp + hf, r = idx / nbc, n = idx % nbc, n_other = (idx ^ 1) % nbc;
                const size_t row0 = (size_t)b * SEQ + r;
                HalfWork W;
                W.Q = PROJ + row0 * LDP + C_DQ + gi * 512 + 64 * h; W.K = PROJ + row0 * LDP + C_DK + gi * 512 + 64 * h; W.V = PROJ + row0 * LDP + C_DV + gi * 512 + 64 * h;
                W.O = const_cast<bf16_t*>(W.Q); W.lse = lsebuf + row0 * 24 + gi * 8 + h;
                W.rsq = W.rsk = W.rsv = W.rso = dil * LDP; W.rsl = dil * 24;
                const float slope = exp2f(-8.f * (float)(gi * 8 + h + 1) / 24.f);
                W.slope2 = slope * (float)dil * LOG2E; W.nback = 128;
                W.ssq = nullptr; W.gqn = nullptr; W.rope = nullptr;
                W.q0A = 128 * n; W.tloA = n > 0 ? 2 * n - 2 : 0; W.nA = 2 * n + 2 - W.tloA; W.q0B = 0; W.tloB = 0; W.nB = 0;
                const int n_oth = n_other > 0 ? 4 : 2;
                for (int rp_ = 0; rp_ < REP_DIL; ++rp_) attn_core<64, false>(lds, W, W.nA > n_oth ? W.nA : n_oth, tid, rp_ == REP_DIL - 1);
            }
            {
                const float* cw = P.in[I_CONVW] + layer * 3 * 512; const float* cb = P.in[I_CONVB] + layer * 512;
                for (int rp_ = 0; rp_ < REP_CONV; ++rp_)
                for (int it = bx * 512 + tid; it < (TC / 8) * 64; it += G * 512) {
                    const int cgp = it & 63, t0 = (it >> 6) * 8, c0 = 8 * cgp;
                    float w0[8], w1[8], w2[8], bb[8], u1[8], u2[8];
#pragma unroll
                    for (int e = 0; e < 8; ++e) { w0[e] = cw[c0 + e]; w1[e] = cw[512 + c0 + e]; w2[e] = cw[1024 + c0 + e]; bb[e] = cb[c0 + e]; u1[e] = 0.f; u2[e] = 0.f; }
                    if ((t0 & (SEQ - 1)) != 0) {
                        const u32x4 x1 = *(const u32x4*)(PROJ + (size_t)(t0 - 1) * LDP + C_AC + c0), x2 = *(const u32x4*)(PROJ + (size_t)(t0 - 2) * LDP + C_AC + c0);
#pragma unroll
                        for (int e = 0; e < 4; ++e) { u1[2 * e] = bf_lo(x1[e]); u1[2 * e + 1] = bf_hi(x1[e]); u2[2 * e] = bf_lo(x2[e]); u2[2 * e + 1] = bf_hi(x2[e]); }
                    }
                    u32x4 vg[8], vu[8];
#pragma unroll
                    for (int tt = 0; tt < 8; ++tt) { const bf16_t* rr = PROJ + (size_t)(t0 + tt) * LDP + c0; vg[tt] = *(const u32x4*)(rr + C_AB); vu[tt] = *(const u32x4*)(rr + C_AC); }
                    __builtin_amdgcn_sched_barrier(0);
#pragma unroll
                    for (int tt = 0; tt < 8; ++tt) {
                        bf16_t* rr = PROJ + (size_t)(t0 + tt) * LDP + c0; u32x4 y;
#pragma unroll
                        for (int e = 0; e < 4; ++e) {
                            const float ua = bf_lo(vu[tt][e]), ub = bf_hi(vu[tt][e]);
                            const float ca = bb[2 * e] + w0[2 * e] * u2[2 * e] + w1[2 * e] * u1[2 * e] + w2[2 * e] * ua;
                            const float cbv = bb[2 * e + 1] + w0[2 * e + 1] * u2[2 * e + 1] + w1[2 * e + 1] * u1[2 * e + 1] + w2[2 * e + 1] * ub;
                            u2[2 * e] = u1[2 * e]; u1[2 * e] = ua; u2[2 * e + 1] = u1[2 * e + 1]; u1[2 * e + 1] = ub;
                            y[e] = cvt_pk_bf16(bf_lo(vg[tt][e]) * ca, bf_hi(vg[tt][e]) * cbv); }
                        if (rp_ == REP_CONV - 1) *(u32x4*)(rr + C_AB) = y; else asm volatile("" :: "v"(y));
                    }
                }
            }
        } else if (k == 2) {
            const int hf = wave >> 2;
            for (int u = ((G & 7) == 0 ? (bx & 7) * (G >> 3) + (bx >> 3) : bx); u < 256; u += G) {
                const int b = u >> 5, hp = (u >> 3) & 3, p = u & 7, h = 2 * hp + hf;
                const int qbA = hf == 0 ? p : 15 - p, qbB = 15 - qbA;
                HalfWork W;
                W.Q = QB + (size_t)b * SEQ * 768 + 96 * h; W.K = KB + (size_t)b * SEQ * 768 + 96 * h; W.V = VB + (size_t)b * SEQ * 512 + 64 * h;
                W.O = PROJ + (size_t)b * SEQ * LDP + C_BZ + 64 * h; W.lse = nullptr;
                W.rsq = 768; W.rsk = 768; W.rsv = 512; W.rso = LDP; W.rsl = 0; W.slope2 = 0.f; W.nback = 1 << 28;
                W.ssq = SS + (size_t)b * SEQ * 8; W.gqn = P.in[I_MQG] + layer * 96; W.rope = ropet;
                W.q0A = 128 * qbA; W.tloA = 0; W.nA = 2 * qbA + 2; W.q0B = 128 * qbB; W.tloB = 0; W.nB = 2 * qbB + 2;
                for (int rp_ = 0; rp_ < REP_MLA; ++rp_) attn_core<96, true>(lds, W, 34, tid, rp_ == REP_MLA - 1);
            }
            for (int rp_ = 0; rp_ < REP_E3; ++rp_)
            for (int m0 = gw; m0 < TC; m0 += 4 * NGW) {
                const int h = lane >> 3, dc = lane & 7;
                u32x4 oa[4], ob[4], oc[4], zz[4]; float la[4], lb[4], lc[4];
#pragma unroll
                for (int r = 0; r < 4; ++r) { const int m = m0 + r * NGW, mc = m < TC ? m : gw; const bf16_t* row = PROJ + (size_t)mc * LDP; const float* ls = lsebuf + (size_t)mc * 24 + h;
                    la[r] = ls[0]; lb[r] = ls[8]; lc[r] = ls[16];
                    oa[r] = *(const u32x4*)(row + C_DQ + 64 * h + 8 * dc); ob[r] = *(const u32x4*)(row + C_DQ + 512 + 64 * h + 8 * dc); oc[r] = *(const u32x4*)(row + C_DQ + 1024 + 64 * h + 8 * dc);
                    zz[r] = *(const u32x4*)(row + C_CZ + 64 * h + 8 * dc); }
                __builtin_amdgcn_sched_barrier(0);
#pragma unroll
                for (int r = 0; r < 4; ++r) { const int m = m0 + r * NGW;
                    const float mx = fmaxf(la[r], fmaxf(lb[r], lc[r]));
                    float a0 = __builtin_amdgcn_exp2f(la[r] - mx), a1 = __builtin_amdgcn_exp2f(lb[r] - mx), a2 = __builtin_amdgcn_exp2f(lc[r] - mx); const float inv = __builtin_amdgcn_rcpf(a0 + a1 + a2); a0 *= inv; a1 *= inv; a2 *= inv;
                    u32x4 y;
#pragma unroll
                    for (int e = 0; e < 4; ++e) {
                        const float lo = (a0 * bf_lo(oa[r][e]) + a1 * bf_lo(ob[r][e]) + a2 * bf_lo(oc[r][e])) * silu_f(bf_lo(zz[r][e]));
                        const float hi = (a0 * bf_hi(oa[r][e]) + a1 * bf_hi(ob[r][e]) + a2 * bf_hi(oc[r][e])) * silu_f(bf_hi(zz[r][e]));
                        y[e] = cvt_pk_bf16(lo, hi); }
                    if (m < TC) { if (rp_ == REP_E3 - 1) *(u32x4*)(PROJ + (size_t)m * LDP + C_CZ + 64 * h + 8 * dc) = y; else asm volatile("" :: "v"(y)); } }
            }
        } else if (k == 3) {
            pg8::MergeOrder S; S.base.init(TC, DM, G, bx);
            for (int rp_ = 0; rp_ < REP_P4; ++rp_) {
            pg8::Gemm g{PROJ, (const bf16_t*)(wl + W_OA), TC, DM, 512, LDP, 512}; pg8::EpiMerge E{PROJ, P.in[I_BGATE] + layer * 3072};
            pg8::gemm_phase<pg8::EpiMerge, pg8::MergeOrder>(lds, g, S, E, tid); asm volatile("" : "+v"(tid)); }
        } else {
            pg8::Gemm g{PROJ + C_MB, (const bf16_t*)(wl + W_O), TC, DM, DM, LDP, DM}; pg8::StaticOrder S; S.init(TC, DM, G, bx);
            if (layer == 0) { pg8::EpiRes<false> E{xin, nullptr, nullptr, PROJ + C_XRAW, SSX}; pg8::gemm_phase<pg8::EpiRes<false>, pg8::StaticOrder>(lds, g, S, E, tid); }
            else { pg8::EpiRes<true> E{nullptr, PROJ + C_XRAW, xout, nullptr, nullptr}; pg8::gemm_phase<pg8::EpiRes<true>, pg8::StaticOrder>(lds, g, S, E, tid); }
            asm volatile("" : "+v"(tid));
            if (layer == 1 && chunk + 1 < NCH) convert_rows(P.in[I_X] + (tok0 + TC) * DM, XB, gw, NGW, lane);
        }
    }
}

constexpr int N_PHASES = 1 + NCH * 11;
constexpr int LDS_BYTES = 147456;

extern "C" void kernel_launch(void* const* d_in, const int* in_sizes, int n_in, void* d_out, int out_size, void* d_ws, size_t ws_size, hipStream_t stream) {
    static int grid = 0;
    if (grid == 0) {
        int dev = 0, cus = 0, per_cu = 0;
        hipGetDevice(&dev);
        hipDeviceGetAttribute(&cus, hipDeviceAttributeMultiprocessorCount, dev);
        hipFuncSetAttribute((const void*)mega, hipFuncAttributeMaxDynamicSharedMemorySize, LDS_BYTES);
        hipOccupancyMaxActiveBlocksPerMultiprocessor(&per_cu, (const void*)mega, 512, LDS_BYTES);
        (void)hipGetLastError();
        grid = cus;
        if (n_in != 18 || ws_size < WS_END || out_size != NB * SEQ * DM) { fprintf(stderr, "kernel_launch: unexpected shapes / workspace\n"); grid = -1; }
    }
    if (grid < 0) return;
    (void)hipMemsetAsync((unsigned char*)d_ws + OFF_BAR, 0, 16384, stream);
    Params p{};
    for (int i = 0; i < 18; ++i) p.in[i] = (const float*)d_in[i];
    p.out = (float*)d_out; p.ws = (unsigned char*)d_ws; p.ph_lo = 0; p.ph_hi = N_PHASES;
    void* args[] = {&p};
    hipError_t e = hipLaunchCooperativeKernel((const void*)mega, dim3(grid), dim3(512), args, LDS_BYTES, stream);
    if (e != hipSuccess) fprintf(stderr, "cooperative launch failed: %s\n", hipGetErrorString(e));
}
```

```cpp
#include <hip/hip_runtime.h>
#include <hip/hip_cooperative_groups.h>
#include <cstdio>
#include <cstdint>
namespace cg = cooperative_groups;

#define LAS __attribute__((address_space(3)))
typedef unsigned short bf16_t;
typedef short bf16x8 __attribute__((ext_vector_type(8)));
typedef float f32x4 __attribute__((ext_vector_type(4)));
typedef float f32x16 __attribute__((ext_vector_type(16)));
typedef unsigned u32x4 __attribute__((ext_vector_type(4)));
typedef unsigned u32x2 __attribute__((ext_vector_type(2)));

constexpr int DM = 1024, NB = 16, SEQ = 2048, CB = 8, TC = CB * SEQ, NCH = NB / CB;
constexpr int LDP = 11264;
constexpr int C_AB = 0, C_AC = 512, C_AX = 1024, C_AZ = 1536, C_CQ = 2048, C_CKV = 2304, C_KPE = 2432, C_BZ = 2560,
              C_DQ = 3072, C_DK = 4608, C_DV = 6144, C_CZ = 7680, C_GATE = 8192;
constexpr int C_XRAW = 1024;
constexpr int C_MB = C_DQ;
constexpr int C_MACC = C_DK;
constexpr float EPS = 1e-6f;
constexpr float LOG2E = 1.4426950408889634f;

constexpr size_t W_IN = 0, W_UQ = (size_t)LDP * 1024 * 2, W_UKV = W_UQ + 768 * 256 * 2, W_OA = W_UKV + 1024 * 128 * 2,
                 W_OB = W_OA + 1024 * 512 * 2, W_OC = W_OB + 1024 * 512 * 2, W_O = W_OC + 1024 * 512 * 2, W_LAYER = W_O + 1024 * 1024 * 2;
constexpr size_t OFF_ROPE = 2 * W_LAYER, OFF_LSE = OFF_ROPE + 2048 * 16 * 8, OFF_SS = OFF_LSE + (size_t)TC * 24 * 4, OFF_SSX = OFF_SS + (size_t)TC * 8 * 4, OFF_R = OFF_SSX + (size_t)TC * 16 * 4;
constexpr size_t OFF_QB = OFF_R, OFF_KB = OFF_QB + (size_t)TC * 768 * 2, OFF_VB = OFF_KB + (size_t)TC * 768 * 2;
constexpr size_t OFF_XB = OFF_R;
constexpr size_t OFF_PROJ = OFF_VB + (size_t)TC * 512 * 2, OFF_BAR = OFF_PROJ + (size_t)TC * LDP * 2, WS_END = OFF_BAR + 16384;
static_assert(OFF_R % 256 == 0 && WS_END <= 536870912ull, "ws map");

typedef float f32x2_t __attribute__((ext_vector_type(2))); typedef __bf16 bf16x2_t __attribute__((ext_vector_type(2)));
__device__ __forceinline__ unsigned cvt_pk_bf16(float lo, float hi) { f32x2_t v = {lo, hi}; bf16x2_t b = __builtin_convertvector(v, bf16x2_t); return __builtin_bit_cast(unsigned, b); }
__device__ __forceinline__ float bf_lo(unsigned w) { return __uint_as_float(w << 16); }
__device__ __forceinline__ float bf_hi(unsigned w) { return __uint_as_float(w & 0xffff0000u); }
__device__ __forceinline__ float wave_sum(float v) {
#pragma unroll
    for (int o = 1; o < 64; o <<= 1) v += __shfl_xor(v, o);
    return v;
}
__device__ __forceinline__ float silu_f(float z) { return z * __builtin_amdgcn_rcpf(1.f + __expf(-z)); }
__device__ __forceinline__ float sigm_f(float z) { return __builtin_amdgcn_rcpf(1.f + __expf(-z)); }

namespace pg8 {
constexpr int BM = 256, BK = 64, HALF = 128, HTB = HALF * BK * 2, STAGE_BYTES = 8 * HTB, NXCD = 8, WGM = 8;
__host__ __device__ __forceinline__ int lds_byte(int r, int c) { const int st = (r >> 4) * 2 + (c >> 5), rr = r & 15, cc = c & 31, ob = rr * 64 + cc * 2; return st * 1024 + (ob ^ (((ob >> 9) & 1) << 5)); }
__host__ __device__ __forceinline__ void stage_rc(int b, int& R, int& C) { const int st = b / 1024, sb = b % 1024, swz = sb ^ (((sb >> 9) & 1) << 5); R = (st >> 1) * 16 + swz / 64; C = (st & 1) * 32 + (swz % 64) / 2; }
__host__ __device__ __forceinline__ int perm32(int rho) { const int n = rho >> 4, i = rho & 15; return 8 * (i >> 2) + 4 * n + (i & 3); }
struct Unit { int pm, pn, br; };
struct Gemm { const bf16_t* A; const bf16_t* Bt; int M, N, K, lda, ldb; };
struct StaticOrder {
    int nM, nN, nwg, G, c;
    __device__ void init(int M, int N, int G_, int c_) { nM = M / BM; nN = N / BM; nwg = nM * nN; G = G_; c = c_; }
    __device__ bool next(int i, Unit& u) const {
        const long L = (long)i * G + c; if (L >= nwg) return false;
        int wgid = (int)L; { const int q = nwg / NXCD, r = nwg % NXCD, xcd = wgid % NXCD, off = wgid / NXCD; wgid = (xcd < r ? xcd * (q + 1) : r * (q + 1) + (xcd - r) * q) + off; }
        const int nig = WGM * nN, gid = wgid / nig, fm = gid * WGM, gsz = (nM - fm) < WGM ? (nM - fm) : WGM;
        u.pm = fm + ((wgid % nig) % gsz); u.pn = (wgid % nig) / gsz; u.br = 0; return true;
    }
    __device__ __forceinline__ size_t aoff(const Unit&) const { return 0; }
    __device__ __forceinline__ size_t boff(const Unit&) const { return 0; }
};
struct MergeOrder {
    StaticOrder base;
    __device__ bool next(int i, Unit& u) const { const int ti = i / 3; if (!base.next(ti, u)) return false; u.br = i - 3 * ti; return true; }
    __device__ __forceinline__ size_t aoff(const Unit& u) const { return (size_t)(u.br == 0 ? C_AB : (u.br == 1 ? C_BZ : C_CZ)) * 2; }
    __device__ __forceinline__ size_t boff(const Unit& u) const { return (size_t)u.br * (1024 * 512 * 2); }
};

template <class Epi, class Sched, bool ALIGN_EPI = true, bool SP2 = true>
__device__ __forceinline__ void gemm_phase(LAS unsigned char* lds, const Gemm g, const Sched& S, const Epi& E, const int tid) {
    const int wid = __builtin_amdgcn_readfirstlane(tid >> 6), lane = tid & 63, wr = wid >> 2, wc = wid & 3, fr = lane & 15, fq = lane >> 4;
    const int K = g.K, nt = K / BK;
    unsigned voffA[2], voffB[2];
#pragma unroll
    for (int i = 0; i < 2; ++i) { int R, C; stage_rc(tid * 16 + i * 8192, R, C); const int Rb = (R & ~31) + perm32(R & 31);
        voffA[i] = (unsigned)(R * g.lda + C) * 2u; voffB[i] = (unsigned)(Rb * g.ldb + C) * 2u; }
    const size_t kstep = (size_t)(BK * 2);
    const size_t hstepA = (size_t)HALF * g.lda * 2, hstepB = (size_t)HALF * g.ldb * 2;
    const size_t tstepA = 2 * hstepA, tstepB = 2 * hstepB;
    const unsigned ldsw = (unsigned)wid * 1024u;
    const int aoff = lds_byte(wr * 64 + fr, fq * 8), boff = lds_byte(wc * 32 + fr, fq * 8);
#define PG8_SA(b, h) (((b) * 2 + (h)) * HTB)
#define PG8_SB(b, h) ((4 + (b) * 2 + (h)) * HTB)
#define PG8_STAGE(bufoff, gbase, voff) do { _Pragma("unroll") for (int _i = 0; _i < 2; ++_i) \
        __builtin_amdgcn_global_load_lds((const unsigned*)((const char*)(gbase) + (voff)[_i]), (LAS unsigned*)(lds + (bufoff) + ldsw + _i * 8192), 16, 0, 0); } while (0)
#define PG8_LDA(dst, b, h) do { _Pragma("unroll") for (int m = 0; m < 4; ++m) _Pragma("unroll") for (int k = 0; k < 2; ++k) dst[m][k] = *(const LAS bf16x8*)(lds + PG8_SA(b, h) + aoff + m * 2048 + k * 1024); } while (0)
#define PG8_LDB(dst, b, h) do { _Pragma("unroll") for (int n = 0; n < 2; ++n) _Pragma("unroll") for (int k = 0; k < 2; ++k) dst[n][k] = *(const LAS bf16x8*)(lds + PG8_SB(b, h) + boff + n * 2048 + k * 1024); } while (0)
#define PG8_MMA(ai, bj, At, Bt) do { __builtin_amdgcn_s_setprio(1); _Pragma("unroll") for (int m = 0; m < 4; ++m) _Pragma("unroll") for (int n = 0; n < 2; ++n) _Pragma("unroll") for (int k = 0; k < 2; ++k) \
        acc[ai][bj][m][n] = __builtin_amdgcn_mfma_f32_16x16x32_bf16(Bt[n][k], At[m][k], acc[ai][bj][m][n], 0, 0, 0); __builtin_amdgcn_s_setprio(0); } while (0)
#define PG8_WAIT_V(n) asm volatile("s_waitcnt vmcnt(" #n ")" ::: "memory")
#define PG8_WAIT_L(n) asm volatile("s_waitcnt lgkmcnt(" #n ")" ::: "memory")
#define PG8_BAR __builtin_amdgcn_s_barrier()
#define PG8_SCHED __builtin_amdgcn_sched_barrier(0)
    Unit cur, nxt; int ui = 0;
    if (!S.next(0, cur)) return;
    f32x4 acc[2][2][4][2];
#pragma unroll
    for (int a = 0; a < 2; ++a)
#pragma unroll
        for (int b = 0; b < 2; ++b)
#pragma unroll
            for (int m = 0; m < 4; ++m)
#pragma unroll
                for (int n = 0; n < 2; ++n) acc[a][b][m][n] = (f32x4){0.f, 0.f, 0.f, 0.f};
    bf16x8 At[4][2], B0[2][2], B1[2][2];
    const char* cA = (const char*)g.A + (size_t)cur.pm * tstepA + S.aoff(cur); const char* cB = (const char*)g.Bt + (size_t)cur.pn * tstepB + S.boff(cur);
    static_assert(SP2, "only the SP2 loop is kept");
    PG8_STAGE(PG8_SB(0, 0), cB, voffB); PG8_STAGE(PG8_SB(0, 1), cB + hstepB, voffB); PG8_STAGE(PG8_SA(0, 0), cA, voffA); PG8_STAGE(PG8_SA(0, 1), cA + hstepA, voffA);
    if (wr == 1) PG8_BAR;
    PG8_WAIT_V(2); PG8_BAR;
    PG8_STAGE(PG8_SB(1, 0), cB + kstep, voffB); PG8_STAGE(PG8_SA(1, 0), cA + kstep, voffA); PG8_STAGE(PG8_SB(1, 1), cB + hstepB + kstep, voffB);
    PG8_WAIT_V(6); PG8_BAR;
    for (;;) {
        const bool has_next = S.next(ui + 1, nxt);
        const char* nA = has_next ? (const char*)g.A + (size_t)nxt.pm * tstepA + S.aoff(nxt) : cA; const char* nB = has_next ? (const char*)g.Bt + (size_t)nxt.pn * tstepB + S.boff(nxt) : cB;
#pragma nounroll
        for (int t = 0; t < nt; t += 2) {
            const bool last = (t == nt - 2);
            const char* a1 = cA + (size_t)(t + 1) * kstep;
            const char* a2 = last ? nA : cA + (size_t)(t + 2) * kstep; const char* b2 = last ? nB : cB + (size_t)(t + 2) * kstep;
            const char* a3 = a2 + kstep; const char* b3 = b2 + kstep;
            PG8_LDB(B0, 0, 0); PG8_LDB(B1, 0, 1); PG8_SCHED; PG8_LDA(At, 0, 0); PG8_STAGE(PG8_SA(1, 1), a1 + hstepA, voffA);
            PG8_WAIT_V(8); PG8_WAIT_L(0); PG8_BAR; PG8_MMA(0, 0, At, B0); PG8_MMA(0, 1, At, B1); PG8_BAR; PG8_SCHED;
            PG8_LDA(At, 0, 1); PG8_STAGE(PG8_SB(0, 0), b2, voffB); PG8_STAGE(PG8_SB(0, 1), b2 + hstepB, voffB); PG8_STAGE(PG8_SA(0, 0), a2, voffA);
            PG8_WAIT_V(8); PG8_WAIT_L(0); PG8_BAR; PG8_MMA(1, 0, At, B0); PG8_MMA(1, 1, At, B1); PG8_BAR; PG8_SCHED;
            PG8_LDB(B0, 1, 0); PG8_LDB(B1, 1, 1); PG8_SCHED; PG8_LDA(At, 1, 0); PG8_STAGE(PG8_SA(0, 1), a2 + hstepA, voffA);
            PG8_WAIT_V(8); PG8_WAIT_L(0); PG8_BAR; PG8_MMA(0, 0, At, B0); PG8_MMA(0, 1, At, B1); PG8_BAR; PG8_SCHED;
            PG8_LDA(At, 1, 1); PG8_STAGE(PG8_SB(1, 0), b3, voffB); PG8_STAGE(PG8_SB(1, 1), b3 + hstepB, voffB); PG8_STAGE(PG8_SA(1, 0), a3, voffA);
            PG8_WAIT_V(8); PG8_WAIT_L(0); PG8_BAR; PG8_MMA(1, 0, At, B0); PG8_MMA(1, 1, At, B1); PG8_BAR; PG8_SCHED;
        }
        if constexpr (ALIGN_EPI) { if (wr == 0) PG8_BAR; }
        E(acc, cur, wr, wc, fr, fq);
        if (!has_next) break;
        if (!(Epi::CHAIN && nxt.br > 0)) {
#pragma unroll
        for (int a = 0; a < 2; ++a)
#pragma unroll
            for (int b = 0; b < 2; ++b)
#pragma unroll
                for (int m = 0; m < 4; ++m)
#pragma unroll
                    for (int n = 0; n < 2; ++n) acc[a][b][m][n] = (f32x4){0.f, 0.f, 0.f, 0.f};
        }
        cur = nxt; cA = nA; cB = nB; ++ui;
        if constexpr (ALIGN_EPI) { if (wr == 1) PG8_BAR; }
    }
    PG8_WAIT_V(0);
    if constexpr (!ALIGN_EPI) { if (wr == 0) PG8_BAR; }
    PG8_BAR;
#undef PG8_SA
#undef PG8_SB
#undef PG8_STAGE
#undef PG8_LDA
#undef PG8_LDB
#undef PG8_MMA
#undef PG8_WAIT_V
#undef PG8_WAIT_L
#undef PG8_BAR
#undef PG8_SCHED
}

struct EpiPlain {
    static constexpr bool CHAIN = false;
    bf16_t* O; int ldc;
    __device__ __forceinline__ void operator()(const f32x4 (&acc)[2][2][4][2], const Unit& u, int wr, int wc, int fr, int fq) const {
        const int row0 = u.pm * BM + wr * 64 + fr, col0 = u.pn * BM + wc * 32 + 8 * fq;
#pragma unroll
        for (int ai = 0; ai < 2; ++ai)
#pragma unroll
            for (int m = 0; m < 4; ++m) { bf16_t* rowp = O + (size_t)(row0 + ai * HALF + m * 16) * ldc + col0;
#pragma unroll
                for (int bj = 0; bj < 2; ++bj) { const f32x4 v0 = acc[ai][bj][m][0], v1 = acc[ai][bj][m][1]; u32x4 w;
                    w.x = cvt_pk_bf16(v0[0], v0[1]); w.y = cvt_pk_bf16(v0[2], v0[3]); w.z = cvt_pk_bf16(v1[0], v1[1]); w.w = cvt_pk_bf16(v1[2], v1[3]);
                    *(u32x4*)(rowp + bj * HALF) = w; } }
    }
};
struct EpiProj {
    static constexpr bool CHAIN = false;
    bf16_t* O; const float* gq; const float* gk;
    float* ss; bool st;
    const float* bgate;
    __device__ __forceinline__ void operator()(const f32x4 (&acc)[2][2][4][2], const Unit& u, int wr, int wc, int fr, int fq) const {
        const int row0 = u.pm * BM + wr * 64 + fr, col0 = u.pn * BM + wc * 64 + 8 * fq;
        if (u.pn < 8) {
            const int ch0 = 64 * u.pn + 16 * wc + 4 * fq;
#pragma unroll
            for (int ai = 0; ai < 2; ++ai)
#pragma unroll
                for (int m = 0; m < 4; ++m) { const int row = u.pm * BM + wr * 64 + fr + ai * HALF + m * 16;
                    const f32x4 ab = acc[ai][0][m][0], ac = acc[ai][0][m][1], ax = acc[ai][1][m][0], az = acc[ai][1][m][1];
                    f32x4 gz, uu = ac * ax;
#pragma unroll
                    for (int i = 0; i < 4; ++i) gz[i] = ab[i] * silu_f(az[i]);
                    bf16_t* rowp = O + (size_t)row * LDP + ch0;
                    if (st) { *(u32x2*)(rowp + C_AB) = (u32x2){cvt_pk_bf16(gz[0], gz[1]), cvt_pk_bf16(gz[2], gz[3])}; *(u32x2*)(rowp + C_AC) = (u32x2){cvt_pk_bf16(uu[0], uu[1]), cvt_pk_bf16(uu[2], uu[3])}; }
                    else asm volatile("" :: "v"(gz), "v"(uu)); }
            return;
        }
        if (u.pn >= 32) {
            const int g0c = (u.pn - 32) * BM + wc * 64 + 8 * fq;
            f32x4 bv[2][2];
#pragma unroll
            for (int bj = 0; bj < 2; ++bj)
#pragma unroll
                for (int n = 0; n < 2; ++n) bv[bj][n] = *(const f32x4*)(bgate + g0c + bj * 32 + n * 4);
#pragma unroll
            for (int ai = 0; ai < 2; ++ai)
#pragma unroll
                for (int m = 0; m < 4; ++m) { const int row = u.pm * BM + wr * 64 + fr + ai * HALF + m * 16;
                    unsigned char* gb = (unsigned char*)(O + (size_t)row * LDP + C_GATE) + g0c;
#pragma unroll
                    for (int bj = 0; bj < 2; ++bj) { u32x2 w;
#pragma unroll
                        for (int n = 0; n < 2; ++n) { const f32x4 x = acc[ai][bj][m][n] + bv[bj][n]; unsigned pk = 0u;
#pragma unroll
                            for (int i = 0; i < 4; ++i) { unsigned qv = (unsigned)(sigm_f(x[i]) * 255.f + 0.5f); qv = qv < 1u ? 1u : qv; pk |= qv << (8 * i); }
                            w[n] = pk; }
                        if (st) *(u32x2*)(gb + bj * 32) = w; else asm volatile("" :: "v"(w)); } }
            return;
        }
        const bool nrm = (u.pn >= 12 && u.pn < 24);
        const bool stat = (u.pn == 8) || (u.pn == 9 && wc < 3);
        f32x4 gv[2][2];
        if (nrm) { const bool isq = u.pn < 18; const int gi = ((u.pn - 12) % 6) >> 1; const float* gp = (isq ? gq : gk) + gi * 64 + 8 * fq; const float post = isq ? 0.125f * LOG2E : 1.f;
#pragma unroll
            for (int bj = 0; bj < 2; ++bj)
#pragma unroll
                for (int n = 0; n < 2; ++n) gv[bj][n] = *(const f32x4*)(gp + bj * 32 + n * 4) * post;
        } else {
#pragma unroll
            for (int bj = 0; bj < 2; ++bj)
#pragma unroll
                for (int n = 0; n < 2; ++n) gv[bj][n] = (f32x4){1.f, 1.f, 1.f, 1.f};
        }
#pragma unroll
        for (int ai = 0; ai < 2; ++ai)
#pragma unroll
            for (int m = 0; m < 4; ++m) {
                const int row = row0 + ai * HALF + m * 16;
                f32x4 v[2][2];
#pragma unroll
                for (int bj = 0; bj < 2; ++bj)
#pragma unroll
                    for (int n = 0; n < 2; ++n) v[bj][n] = acc[ai][bj][m][n];
                float r = 1.f;
                if (nrm || stat) { float ss_ = 0.f;
#pragma unroll
                    for (int bj = 0; bj < 2; ++bj)
#pragma unroll
                        for (int n = 0; n < 2; ++n) { const f32x4 x = v[bj][n]; ss_ += (x[0] * x[0] + x[1] * x[1]) + (x[2] * x[2] + x[3] * x[3]); }
                    ss_ += __shfl_xor(ss_, 16); ss_ += __shfl_xor(ss_, 32);
                    if (nrm) r = rsqrtf(ss_ * (1.f / 64.f) + EPS);
                    else if (fq == 0) ss[(size_t)row * 8 + (u.pn == 8 ? wc : 4 + wc)] = ss_; }
                bf16_t* rowp = O + (size_t)row * LDP + col0;
#pragma unroll
                for (int bj = 0; bj < 2; ++bj) { const f32x4 v0 = v[bj][0] * r * gv[bj][0], v1 = v[bj][1] * r * gv[bj][1]; u32x4 w;
                    w.x = cvt_pk_bf16(v0[0], v0[1]); w.y = cvt_pk_bf16(v0[2], v0[3]); w.z = cvt_pk_bf16(v1[0], v1[1]); w.w = cvt_pk_bf16(v1[2], v1[3]);
                    if (st) *(u32x4*)(rowp + bj * 32) = w; else asm volatile("" :: "v"(w)); } }
    }
};
struct EpiKV {
    static constexpr bool CHAIN = false;
    bf16_t* KBo; bf16_t* VBo; const bf16_t* proj; const float* ss; const float* gk; const float* rope;
    __device__ __forceinline__ void operator()(const f32x4 (&acc)[2][2][4][2], const Unit& u, int wr, int wc, int fr, int fq) const {
        const int row0 = u.pm * BM + wr * 64 + fr; const int wu = 4 * u.pn + wc;
        if (wu < 8) {
            f32x4 gv[2][2];
#pragma unroll
            for (int bj = 0; bj < 2; ++bj)
#pragma unroll
                for (int n = 0; n < 2; ++n) gv[bj][n] = *(const f32x4*)(gk + bj * 32 + 8 * fq + n * 4);
            const f32x4 g1 = *(const f32x4*)(gk + 64 + 4 * fq), g2 = *(const f32x4*)(gk + 80 + 4 * fq);
#pragma unroll
            for (int ai = 0; ai < 2; ++ai) {
                f32x4 s4h[4];
#pragma unroll
                for (int m = 0; m < 4; ++m) s4h[m] = *(const f32x4*)(ss + (size_t)(row0 + ai * HALF + m * 16) * 8 + 4);
                __builtin_amdgcn_sched_barrier(0);
#pragma unroll
                for (int m = 0; m < 4; ++m) {
                    const int row = row0 + ai * HALF + m * 16;
                    const f32x4 s4 = s4h[m];
                    const float rkv = rsqrtf((s4.x + s4.y) * (1.f / 128.f) + EPS);
                    f32x4 v[2][2]; float q = 0.f;
#pragma unroll
                    for (int bj = 0; bj < 2; ++bj)
#pragma unroll
                        for (int n = 0; n < 2; ++n) { v[bj][n] = acc[ai][bj][m][n] * rkv; const f32x4 x = v[bj][n]; q += (x[0] * x[0] + x[1] * x[1]) + (x[2] * x[2] + x[3] * x[3]); }
                    q += __shfl_xor(q, 16); q += __shfl_xor(q, 32);
                    const float rk = rsqrtf((q + s4.z) * (1.f / 96.f) + EPS);
                    bf16_t* kr = KBo + (size_t)row * 768 + 96 * wu;
#pragma unroll
                    for (int bj = 0; bj < 2; ++bj) { const f32x4 v0 = v[bj][0] * rk * gv[bj][0], v1 = v[bj][1] * rk * gv[bj][1]; u32x4 w;
                        w.x = cvt_pk_bf16(v0[0], v0[1]); w.y = cvt_pk_bf16(v0[2], v0[3]); w.z = cvt_pk_bf16(v1[0], v1[1]); w.w = cvt_pk_bf16(v1[2], v1[3]);
                        *(u32x4*)(kr + bj * 32 + 8 * fq) = w; }
                    const bf16_t* pe = proj + (size_t)row * LDP + C_KPE;
                    const u32x2 a = *(const u32x2*)(pe + 4 * fq), b = *(const u32x2*)(pe + 16 + 4 * fq);
                    const int pos = row & (SEQ - 1);
                    const f32x4 cs0 = *(const f32x4*)(rope + (size_t)(pos * 16 + 4 * fq) * 2), cs1 = *(const f32x4*)(rope + (size_t)(pos * 16 + 4 * fq) * 2 + 4);
                    const f32x4 t1 = (f32x4){bf_lo(a.x), bf_hi(a.x), bf_lo(a.y), bf_hi(a.y)} * g1 * rk, t2 = (f32x4){bf_lo(b.x), bf_hi(b.x), bf_lo(b.y), bf_hi(b.y)} * g2 * rk;
                    const f32x4 cc = (f32x4){cs0.x, cs0.z, cs1.x, cs1.z}, sn = (f32x4){cs0.y, cs0.w, cs1.y, cs1.w};
                    const f32x4 o1 = t1 * cc - t2 * sn, o2 = t2 * cc + t1 * sn;
                    *(u32x2*)(kr + 64 + 4 * fq) = (u32x2){cvt_pk_bf16(o1[0], o1[1]), cvt_pk_bf16(o1[2], o1[3])};
                    *(u32x2*)(kr + 80 + 4 * fq) = (u32x2){cvt_pk_bf16(o2[0], o2[1]), cvt_pk_bf16(o2[2], o2[3])};
                }
            }
        } else {
            typedef float f32x2v __attribute__((ext_vector_type(2)));
            f32x2v s2v[2][4];
#pragma unroll
            for (int ai = 0; ai < 2; ++ai)
#pragma unroll
                for (int m = 0; m < 4; ++m) s2v[ai][m] = *(const f32x2v*)(ss + (size_t)(row0 + ai * HALF + m * 16) * 8 + 4);
            __builtin_amdgcn_sched_barrier(0);
#pragma unroll
            for (int ai = 0; ai < 2; ++ai)
#pragma unroll
                for (int m = 0; m < 4; ++m) {
                    const int row = row0 + ai * HALF + m * 16;
                    const float rkv = rsqrtf((s2v[ai][m].x + s2v[ai][m].y) * (1.f / 128.f) + EPS);
                    bf16_t* vr = VBo + (size_t)row * 512 + 64 * (wu - 8);
#pragma unroll
                    for (int bj = 0; bj < 2; ++bj) { const f32x4 v0 = acc[ai][bj][m][0] * rkv, v1 = acc[ai][bj][m][1] * rkv; u32x4 w;
                        w.x = cvt_pk_bf16(v0[0], v0[1]); w.y = cvt_pk_bf16(v0[2], v0[3]); w.z = cvt_pk_bf16(v1[0], v1[1]); w.w = cvt_pk_bf16(v1[2], v1[3]);
                        *(u32x4*)(vr + bj * 32 + 8 * fq) = w; } }
        }
    }
};
struct EpiMerge {
    static constexpr bool CHAIN = true;
    const bf16_t* proj; const float* bgate;
    __device__ __forceinline__ void operator()(f32x4 (&acc)[2][2][4][2], const Unit& u, int wr, int wc, int fr, int fq) const {
        const int row0 = u.pm * BM + wr * 64 + fr, col0 = u.pn * BM + wc * 32 + 8 * fq; const int BR = u.br;
        const bool last = BR == 2; const int BD = last ? BR : BR + 1;
        u32x2 gN[2][2], gD[2][2];
#define MG_LOAD(R, SET) do { const unsigned char* ga_ = (const unsigned char*)(proj + (size_t)(row0 + ((R) >> 2) * HALF + ((R) & 3) * 16) * LDP + C_GATE); \
            _Pragma("unroll") for (int bj_ = 0; bj_ < 2; ++bj_) { const int c_ = col0 + bj_ * HALF; \
                gN[SET][bj_] = *(const u32x2*)(ga_ + BR * 1024 + c_); gD[SET][bj_] = *(const u32x2*)(ga_ + BD * 1024 + c_); } } while (0)
        MG_LOAD(0, 0);
#pragma unroll
        for (int r = 0; r < 8; ++r) {
            const int ai = r >> 2, m = r & 3;
            if (r + 1 < 8) { if ((r & 1) == 0) MG_LOAD(r + 1, 1); else MG_LOAD(r + 1, 0); }
            __builtin_amdgcn_sched_barrier(0);
#pragma unroll
            for (int bj = 0; bj < 2; ++bj) { const size_t rb = (size_t)(row0 + ai * HALF + m * 16) * LDP; const int c = col0 + bj * HALF;
                const u32x2 gn = gN[r & 1][bj], gd = gD[r & 1][bj];
                f32x4 f0, f1;
#pragma unroll
                for (int i = 0; i < 4; ++i) {
                    const float n0 = (float)((gn.x >> (8 * i)) & 255u), n1 = (float)((gn.y >> (8 * i)) & 255u);
                    const float d0 = last ? 255.f : (float)((gd.x >> (8 * i)) & 255u), d1 = last ? 255.f : (float)((gd.y >> (8 * i)) & 255u);
                    f0[i] = n0 * __builtin_amdgcn_rcpf(d0); f1[i] = n1 * __builtin_amdgcn_rcpf(d1); }
                acc[ai][bj][m][0] *= f0; acc[ai][bj][m][1] *= f1;
                if (last) { const f32x4 v0 = acc[ai][bj][m][0], v1 = acc[ai][bj][m][1];
                    u32x4 w; w.x = cvt_pk_bf16(v0[0], v0[1]); w.y = cvt_pk_bf16(v0[2], v0[3]); w.z = cvt_pk_bf16(v1[0], v1[1]); w.w = cvt_pk_bf16(v1[2], v1[3]);
                    *(u32x4*)(const_cast<bf16_t*>(proj) + rb + C_MB + c) = w; } }
            __builtin_amdgcn_sched_barrier(0);
        }
#undef MG_LOAD
    }
};
template <bool BF_IN> struct EpiRes {
    static constexpr bool CHAIN = false;
    const float* xin; const bf16_t* xinb; float* out; bf16_t* xb; float* ssx;
    __device__ __forceinline__ void operator()(const f32x4 (&acc)[2][2][4][2], const Unit& u, int wr, int wc, int fr, int fq) const {
        const int row0 = u.pm * BM + wr * 64 + fr, col0 = u.pn * BM + wc * 32 + 8 * fq;
#pragma unroll
        for (int aq = 0; aq < 4; ++aq) { const int ai = aq >> 1, m0 = (aq & 1) * 2;
            f32x4 xa[2][2], xc[2][2];
#pragma unroll
            for (int mm = 0; mm < 2; ++mm)
#pragma unroll
                for (int bj = 0; bj < 2; ++bj) { const int row = row0 + ai * HALF + (m0 + mm) * 16;
                    if (BF_IN) { const u32x4 w = *(const u32x4*)(xinb + (size_t)row * LDP + col0 + bj * HALF);
                        xa[mm][bj] = (f32x4){bf_lo(w.x), bf_hi(w.x), bf_lo(w.y), bf_hi(w.y)}; xc[mm][bj] = (f32x4){bf_lo(w.z), bf_hi(w.z), bf_lo(w.w), bf_hi(w.w)}; }
                    else { const size_t off = (size_t)row * DM + col0 + bj * HALF; xa[mm][bj] = *(const f32x4*)(xin + off); xc[mm][bj] = *(const f32x4*)(xin + off + 4); } }
            __builtin_amdgcn_sched_barrier(0);
#pragma unroll
            for (int mm = 0; mm < 2; ++mm) { const int m = m0 + mm; const int row = row0 + ai * HALF + m * 16; const size_t off = (size_t)row * DM + col0; float q = 0.f;
#pragma unroll
                for (int bj = 0; bj < 2; ++bj) { const f32x4 a = xa[mm][bj] + acc[ai][bj][m][0], b = xc[mm][bj] + acc[ai][bj][m][1];
                    if (BF_IN) { *(f32x4*)(out + off + bj * HALF) = a; *(f32x4*)(out + off + bj * HALF + 4) = b; }
                    else { q += (a[0] * a[0] + a[1] * a[1]) + (a[2] * a[2] + a[3] * a[3]) + (b[0] * b[0] + b[1] * b[1]) + (b[2] * b[2] + b[3] * b[3]);
                        u32x4 w; w.x = cvt_pk_bf16(a[0], a[1]); w.y = cvt_pk_bf16(a[2], a[3]); w.z = cvt_pk_bf16(b[0], b[1]); w.w = cvt_pk_bf16(b[2], b[3]);
                        *(u32x4*)(xb + (size_t)row * LDP + col0 + bj * HALF) = w; } }
                if (!BF_IN) { q += __shfl_xor(q, 16); q += __shfl_xor(q, 32); if (fq == 0) ssx[(size_t)row * 16 + 4 * u.pn + wc] = q; } }
            __builtin_amdgcn_sched_barrier(0);
        }
    }
};
}

struct HalfWork {
    const bf16_t *Q, *K, *V; bf16_t* O; float* lse;
    int rsq, rsk, rsv, rso, rsl;
    float slope2; int nback;
    const float *ssq, *gqn, *rope;
    int q0A, tloA, nA, q0B, tloB, nB;
};
template <int DK, bool MLA>
__device__ __forceinline__ void attn_core(LAS unsigned char* lds, const HalfWork& W, const int NS, const int tid, const bool do_store = true) {
    const int lane = tid & 63, r32 = lane & 31, hi = lane >> 5;
    const int wid = __builtin_amdgcn_readfirstlane(tid >> 6), hf = wid >> 2, w4 = wid & 3, ht = tid & 255;
    constexpr int KSTR = DK * 2 + 16, VSTR = 136, KBYTES = 64 * KSTR, BUFB = KBYTES + 64 * VSTR;
    constexpr int KP = DK / 8, KPT = (64 * KP) / 256;
    LAS unsigned char* hb = lds + hf * (2 * BUFB);
    u32x4 kreg[KPT], vreg[2];
    bf16x8 qf[DK / 16];
    float m_run = -INFINITY, l_run = 0.f; f32x16 o0 = {}, o1 = {};
    const int ntot = W.nA + W.nB;
#define ATT_LOADT(s) do { const bool a_ = (s) < W.nA; const int t_ = a_ ? (W.tloA + (s)) : (W.tloB + (s) - W.nA); \
        const bf16_t* kp_ = W.K + (long)(64 * t_) * W.rsk; const bf16_t* vp_ = W.V + (long)(64 * t_) * W.rsv; \
        _Pragma("unroll") for (int i_ = 0; i_ < KPT; ++i_) { const int idx_ = ht + 256 * i_, row_ = idx_ / KP, ch_ = idx_ % KP; kreg[i_] = *(const u32x4*)(kp_ + (long)row_ * W.rsk + ch_ * 8); } \
        _Pragma("unroll") for (int i_ = 0; i_ < 2; ++i_) { const int idx_ = ht + 256 * i_, row_ = idx_ >> 3, ch_ = idx_ & 7; vreg[i_] = *(const u32x4*)(vp_ + (long)row_ * W.rsv + ch_ * 8); } } while (0)
#define ATT_WRITET(buf) do { LAS unsigned char* kb_ = hb + (buf) * BUFB; \
        _Pragma("unroll") for (int i_ = 0; i_ < KPT; ++i_) { const int idx_ = ht + 256 * i_, row_ = idx_ / KP, ch_ = idx_ % KP; *(LAS u32x4*)(kb_ + row_ * KSTR + ch_ * 16) = kreg[i_]; } \
        _Pragma("unroll") for (int i_ = 0; i_ < 2; ++i_) { const int idx_ = ht + 256 * i_, row_ = idx_ >> 3, ch_ = idx_ & 7; \
            _Pragma("unroll") for (int e_ = 0; e_ < 8; ++e_) { const unsigned w_ = vreg[i_][e_ >> 1]; \
                *(LAS unsigned short*)(kb_ + KBYTES + (8 * ch_ + e_) * VSTR + row_ * 2) = (unsigned short)((e_ & 1) ? (w_ >> 16) : (w_ & 0xffffu)); } } } while (0)
    if (ntot > 0) { ATT_LOADT(0); ATT_WRITET(0); }
    __syncthreads();
    for (int s = 0; s < NS; ++s) {
        if (s + 1 < ntot) ATT_LOADT(s + 1);
        if (s < ntot) {
            const bool inA = s < W.nA; const int js = inA ? s : s - W.nA;
            const int q0 = inA ? W.q0A : W.q0B; const int t = (inA ? W.tloA : W.tloB) + js; const int nj = inA ? W.nA : W.nB;
            const int qrow = q0 + w4 * 32 + r32;
            if (js == 0) {
                const bf16_t* qp = W.Q + (long)qrow * W.rsq + hi * 8;
#pragma unroll
                for (int ds = 0; ds < DK / 16; ++ds) qf[ds] = *(const bf16x8*)(qp + ds * 16);
                m_run = -INFINITY; l_run = 0.f; o0 = (f32x16){}; o1 = (f32x16){};
                if (MLA) {
                    float qv[DK / 16][8]; float ssl = 0.f;
#pragma unroll
                    for (int ds = 0; ds < DK / 16; ++ds) { const u32x4 w = __builtin_bit_cast(u32x4, qf[ds]);
#pragma unroll
                        for (int e = 0; e < 4; ++e) { qv[ds][2 * e] = bf_lo(w[e]); qv[ds][2 * e + 1] = bf_hi(w[e]); ssl += qv[ds][2 * e] * qv[ds][2 * e] + qv[ds][2 * e + 1] * qv[ds][2 * e + 1]; } }
                    ssl += __shfl_xor(ssl, 32);
                    const f32x4 s4 = *(const f32x4*)(W.ssq + (size_t)qrow * 8);
                    const float rq = rsqrtf(((s4.x + s4.y) + (s4.z + s4.w)) * (1.f / 256.f) + EPS);
                    const float rn = rsqrtf(ssl * rq * rq * (1.f / 96.f) + EPS) * rq * (0.10206207261596575f * LOG2E);
#pragma unroll
                    for (int ds = 0; ds < DK / 16; ++ds) { const f32x4 ga = *(const f32x4*)(W.gqn + 16 * ds + 8 * hi), gb = *(const f32x4*)(W.gqn + 16 * ds + 8 * hi + 4);
#pragma unroll
                        for (int e = 0; e < 4; ++e) { qv[ds][e] *= rn * ga[e]; qv[ds][4 + e] *= rn * gb[e]; } }
                    const float* rp = W.rope + (size_t)(qrow * 16 + 8 * hi) * 2;
#pragma unroll
                    for (int e2 = 0; e2 < 4; ++e2) { const f32x4 cs = *(const f32x4*)(rp + 4 * e2);
                        { const float t1 = qv[DK / 16 - 2][2 * e2], t2 = qv[DK / 16 - 1][2 * e2]; qv[DK / 16 - 2][2 * e2] = t1 * cs.x - t2 * cs.y; qv[DK / 16 - 1][2 * e2] = t2 * cs.x + t1 * cs.y; }
                        { const float t1 = qv[DK / 16 - 2][2 * e2 + 1], t2 = qv[DK / 16 - 1][2 * e2 + 1]; qv[DK / 16 - 2][2 * e2 + 1] = t1 * cs.z - t2 * cs.w; qv[DK / 16 - 1][2 * e2 + 1] = t2 * cs.z + t1 * cs.w; } }
#pragma unroll
                    for (int ds = 0; ds < DK / 16; ++ds) { u32x4 w;
#pragma unroll
                        for (int e = 0; e < 4; ++e) w[e] = cvt_pk_bf16(qv[ds][2 * e], qv[ds][2 * e + 1]);
                        qf[ds] = __builtin_bit_cast(bf16x8, w); }
                }
            }
            const int qs = q0 + w4 * 32;
            const bool useful = (64 * t <= qs + 31) && (64 * t + 63 >= qs - W.nback);
            if (useful) {
                LAS const unsigned char* Kl = hb + (s & 1) * BUFB; LAS const unsigned char* Vl = Kl + KBYTES;
                f32x16 p0 = {}, p1 = {};
                bf16x8 kfa[DK / 16], kfb[DK / 16];
#pragma unroll
                for (int ds = 0; ds < DK / 16; ++ds) {
                    kfa[ds] = *(LAS const bf16x8*)(Kl + r32 * KSTR + ds * 32 + hi * 16);
                    kfb[ds] = *(LAS const bf16x8*)(Kl + (32 + r32) * KSTR + ds * 32 + hi * 16);
                }
                __builtin_amdgcn_sched_barrier(0);
#pragma unroll
                for (int ds = 0; ds < DK / 16; ++ds) {
                    p0 = __builtin_amdgcn_mfma_f32_32x32x16_bf16(kfa[ds], qf[ds], p0, 0, 0, 0);
                    p1 = __builtin_amdgcn_mfma_f32_32x32x16_bf16(kfb[ds], qf[ds], p1, 0, 0, 0);
                }
                u32x4 vfa[4], vfb[4];
#pragma unroll
                for (int ks = 0; ks < 4; ++ks) {
                    { LAS const unsigned char* va = Vl + r32 * VSTR + (16 * ks + 4 * hi) * 2; const u32x2 lo = *(LAS const u32x2*)va, hh = *(LAS const u32x2*)(va + 16); vfa[ks] = (u32x4){lo.x, lo.y, hh.x, hh.y}; }
                    { LAS const unsigned char* va = Vl + (32 + r32) * VSTR + (16 * ks + 4 * hi) * 2; const u32x2 lo = *(LAS const u32x2*)va, hh = *(LAS const u32x2*)(va + 16); vfb[ks] = (u32x4){lo.x, lo.y, hh.x, hh.y}; }
                }
                __builtin_amdgcn_sched_barrier(0);
                const bool full = MLA && (64 * t + 63 <= qs);
                if (!full) {
                    const int kb = 64 * t + 4 * hi;
#pragma unroll
                    for (int r = 0; r < 16; ++r) { const int d0 = qrow - (kb + (r & 3) + 8 * (r >> 2)), d1 = d0 - 32;
                        p0[r] = (d0 >= 0 && d0 <= W.nback) ? (MLA ? p0[r] : p0[r] - W.slope2 * (float)d0) : -INFINITY;
                        p1[r] = (d1 >= 0 && d1 <= W.nback) ? (MLA ? p1[r] : p1[r] - W.slope2 * (float)d1) : -INFINITY; }
                }
                float mx = fmaxf(p0[0], p1[0]);
#pragma unroll
                for (int r = 1; r < 16; ++r) mx = fmaxf(mx, fmaxf(p0[r], p1[r]));
                mx = fmaxf(mx, __shfl_xor(mx, 32));
                const float mnew = fmaxf(m_run, mx);
                const float muse = (mnew == -INFINITY) ? 0.f : mnew;
                const float alpha = __builtin_amdgcn_exp2f(m_run - muse);
                m_run = mnew;
                float rs = 0.f;
#pragma unroll
                for (int r = 0; r < 16; ++r) { p0[r] = __builtin_amdgcn_exp2f(p0[r] - muse); p1[r] = __builtin_amdgcn_exp2f(p1[r] - muse); rs += p0[r] + p1[r]; }
                l_run = l_run * alpha + rs;
#pragma unroll
                for (int r = 0; r < 16; ++r) { o0[r] *= alpha; o1[r] *= alpha; }
                u32x4 pw[4];
#pragma unroll
                for (int e = 0; e < 4; ++e) { pw[0][e] = cvt_pk_bf16(p0[2 * e], p0[2 * e + 1]); pw[1][e] = cvt_pk_bf16(p0[8 + 2 * e], p0[9 + 2 * e]);
                    pw[2][e] = cvt_pk_bf16(p1[2 * e], p1[2 * e + 1]); pw[3][e] = cvt_pk_bf16(p1[8 + 2 * e], p1[9 + 2 * e]); }
#pragma unroll
                for (int ks = 0; ks < 4; ++ks) {
                    const bf16x8 pb = __builtin_bit_cast(bf16x8, pw[ks]);
                    o0 = __builtin_amdgcn_mfma_f32_32x32x16_bf16(__builtin_bit_cast(bf16x8, vfa[ks]), pb, o0, 0, 0, 0);
                    o1 = __builtin_amdgcn_mfma_f32_32x32x16_bf16(__builtin_bit_cast(bf16x8, vfb[ks]), pb, o1, 0, 0, 0);
                }
            }
            if (js == nj - 1 && do_store) {
                const float l = l_run + __shfl_xor(l_run, 32); const float inv = 1.f / l;
                bf16_t* op = W.O + (long)qrow * W.rso + 4 * hi;
#pragma unroll
                for (int j = 0; j < 4; ++j) {
                    float a0 = o0[4 * j] * inv, a1 = o0[4 * j + 1] * inv, a2 = o0[4 * j + 2] * inv, a3 = o0[4 * j + 3] * inv;
                    float b0 = o1[4 * j] * inv, b1 = o1[4 * j + 1] * inv, b2 = o1[4 * j + 2] * inv, b3 = o1[4 * j + 3] * inv;
                    if (MLA) { const u32x2 za = *(const u32x2*)(op + 8 * j), zb = *(const u32x2*)(op + 32 + 8 * j);
                        a0 *= silu_f(bf_lo(za.x)); a1 *= silu_f(bf_hi(za.x)); a2 *= silu_f(bf_lo(za.y)); a3 *= silu_f(bf_hi(za.y));
                        b0 *= silu_f(bf_lo(zb.x)); b1 *= silu_f(bf_hi(zb.x)); b2 *= silu_f(bf_lo(zb.y)); b3 *= silu_f(bf_hi(zb.y)); }
                    *(u32x2*)(op + 8 * j) = (u32x2){cvt_pk_bf16(a0, a1), cvt_pk_bf16(a2, a3)};
                    *(u32x2*)(op + 32 + 8 * j) = (u32x2){cvt_pk_bf16(b0, b1), cvt_pk_bf16(b2, b3)};
                }
                if (!MLA) { if (hi == 0) W.lse[(long)qrow * W.rsl] = m_run + __builtin_amdgcn_logf(l); }
            }
        }
        if (s + 1 < ntot) ATT_WRITET((s + 1) & 1);
        __syncthreads();
    }
#undef ATT_LOADT
#undef ATT_WRITET
}


#define XB_TMO      128
#define XB_XCNT(j)  (256  + 64 * (j))
#define XB_XSUB(j)  (1280 + 64 * (j))
#define XB_XGEN(j)  (2304 + 64 * (j))
#define XB_TOP      3328
#define XB_TOPGEN   3392
#define XCD_BAR_WORDS 3456
#define XB_SPIN_CAP (1u << 18)
__device__ __forceinline__ unsigned xb_ld(unsigned* p)              { return __hip_atomic_load(p, __ATOMIC_RELAXED, __HIP_MEMORY_SCOPE_AGENT); }
__device__ __forceinline__ unsigned xb_add(unsigned* p, unsigned v) { return __hip_atomic_fetch_add(p, v, __ATOMIC_RELAXED, __HIP_MEMORY_SCOPE_AGENT); }
__device__ __forceinline__ unsigned xb_xcc_id() { return (unsigned)__builtin_amdgcn_s_getreg((3 << 11) | 20) & 0xFu; }
#define XB_SPIN(cond, bar) do { unsigned _sp = 0; while (cond) { __builtin_amdgcn_s_sleep(1); \
    if ((++_sp & 255u) == 0u) { if (xb_ld(&(bar)[XB_TMO])) break; if (_sp > XB_SPIN_CAP) { atomicAdd(&(bar)[XB_TMO], 1u); break; } } } } while (0)
struct XcdBarrier { unsigned* bar; unsigned x; volatile LAS unsigned* st; };
__device__ __forceinline__ XcdBarrier xcd_barrier_post(unsigned* bar, volatile LAS unsigned* st) {
    XcdBarrier b; b.bar = bar; b.x = xb_xcc_id(); b.st = st;
    if (threadIdx.x == 0) (void)xb_add(&bar[XB_XCNT(b.x)], 1u);
    return b;
}
__device__ __forceinline__ void xcd_barrier_complete(unsigned* bar, unsigned x, unsigned& nloc, unsigned& nx) {
    const unsigned G = gridDim.x * gridDim.y * gridDim.z;
    unsigned sum, cnt, mine, sp = 0u;
    for (;;) {
        sum = 0u; cnt = 0u; mine = 0u;
#pragma unroll
        for (unsigned j = 0; j < 16; ++j) { const unsigned c = xb_ld(&bar[XB_XCNT(j)]); sum += c; cnt += (c > 0u) ? 1u : 0u; mine = (j == x) ? c : mine; }
        if (sum == G) break;
        __builtin_amdgcn_s_sleep(1);
        if ((++sp & 255u) == 0u) { if (xb_ld(&bar[XB_TMO])) break; if (sp > XB_SPIN_CAP) { atomicAdd(&bar[XB_TMO], 1u); break; } }
    }
    nloc = mine > 0u ? mine : 1u; nx = cnt > 0u ? cnt : 1u;
}
__device__ __forceinline__ void xcd_barrier(const XcdBarrier& b) {
    asm volatile("s_waitcnt vmcnt(0)" ::: "memory");
    __syncthreads();
    if (threadIdx.x == 0) {
        unsigned* bar = b.bar;
        __builtin_amdgcn_s_waitcnt(0);
        unsigned nloc = b.st[0], nx = b.st[1];
        if (nloc == 0u) { xcd_barrier_complete(bar, b.x, nloc, nx); b.st[0] = nloc; b.st[1] = nx; }
        const unsigned old = xb_add(&bar[XB_XSUB(b.x)], 1u);
        const unsigned gen = old / nloc;
        if (old + 1u == (gen + 1u) * nloc) {
            __builtin_amdgcn_fence(__ATOMIC_RELEASE, "agent");
            asm volatile("s_waitcnt vmcnt(0)" ::: "memory");
            const unsigned og = xb_add(&bar[XB_TOP], 1u);
            const unsigned tg = og / nx;
            if (og + 1u == (tg + 1u) * nx) xb_add(&bar[XB_TOPGEN], 1u);
            else XB_SPIN(xb_ld(&bar[XB_TOPGEN]) == tg, bar);
            __builtin_amdgcn_fence(__ATOMIC_ACQUIRE, "agent");
            xb_add(&bar[XB_XGEN(b.x)], 1u);
            asm volatile("s_waitcnt vmcnt(0)" ::: "memory");
        } else {
            XB_SPIN(xb_ld(&bar[XB_XGEN(b.x)]) == gen, bar);
            __builtin_amdgcn_fence(__ATOMIC_ACQUIRE, "agent");
            asm volatile("s_waitcnt vmcnt(0)" ::: "memory");
        }
    }
    __syncthreads();
}

#ifndef REP_SYNC
#define REP_SYNC 1
#endif
#ifndef REP_P1
#define REP_P1 1
#endif
#ifndef REP_MLA
#define REP_MLA 1
#endif
#ifndef REP_DIL
#define REP_DIL 1
#endif
#ifndef REP_P4
#define REP_P4 1
#endif
#ifndef REP_P2
#define REP_P2 1
#endif
#ifndef P1_NOSTORE
#define P1_NOSTORE 0
#endif
#ifndef REP_PRO
#define REP_PRO 1
#endif
#ifndef REP_E3
#define REP_E3 1
#endif
#ifndef REP_CONV
#define REP_CONV 1
#endif
#ifndef REP_P5
#define REP_P5 1
#endif
struct Params { const float* in[18]; float* out; unsigned char* ws; int ph_lo, ph_hi; };
enum { I_X = 0, I_NORMG, I_WIN, I_BGATE, I_CONVW, I_CONVB, I_QAG, I_WUQ, I_KVAG, I_WUKV, I_MQG, I_MKG, I_DQG, I_DKG, I_WOA, I_WOB, I_WOC, I_WO };

__device__ __forceinline__ void transpose_item(const float* W, int ldw, int K, int src_col0, bf16_t* WT, int dst_row0, int k0, LAS float* scr, int lane, const float* ks = nullptr, int mixa_kb = -1) {
    if (src_col0 >= 0) {
        float wv[32], sv[32];
#pragma unroll
        for (int i = 0; i < 32; ++i) { const int kk = 2 * i + (lane >> 5); const int e_ = lane & 31; const int col_ = mixa_kb < 0 ? src_col0 + e_ : 512 * (mixa_kb + ((e_ >> 2) & 1)) + src_col0 + 4 * (e_ >> 3) + (e_ & 3); wv[i] = W[(size_t)(k0 + kk) * ldw + col_]; sv[i] = ks ? ks[k0 + kk] : 1.f; }
        __builtin_amdgcn_sched_barrier(0);
#pragma unroll
        for (int i = 0; i < 32; ++i) { const int kk = 2 * i + (lane >> 5); scr[kk * 33 + (lane & 31)] = wv[i] * sv[i]; }
    } else {
#pragma unroll 8
        for (int i = 0; i < 32; ++i) { const int kk = 2 * i + (lane >> 5); scr[kk * 33 + (lane & 31)] = 0.f; }
    }
    asm volatile("s_waitcnt lgkmcnt(0)" ::: "memory");
    const int c = lane & 7;
#pragma unroll
    for (int j = 0; j < 4; ++j) { const int n = (lane >> 3) + 8 * j; const LAS float* s = scr + (8 * c) * 33 + n;
        u32x4 o; o.x = cvt_pk_bf16(s[0 * 33], s[1 * 33]); o.y = cvt_pk_bf16(s[2 * 33], s[3 * 33]); o.z = cvt_pk_bf16(s[4 * 33], s[5 * 33]); o.w = cvt_pk_bf16(s[6 * 33], s[7 * 33]);
        *(u32x4*)(WT + (size_t)(dst_row0 + n) * K + k0 + 8 * c) = o; }
    asm volatile("s_waitcnt lgkmcnt(0)" ::: "memory");
}

__device__ __forceinline__ void convert_rows(const float* x, bf16_t* xb, int gw, int NGW, int lane) {
    for (int m0 = gw; m0 < TC; m0 += 4 * NGW) {
        f32x4 v[4][4];
#pragma unroll
        for (int r = 0; r < 4; ++r) { const int m = m0 + r * NGW; const f32x4* xr = (const f32x4*)(x + (size_t)(m < TC ? m : gw) * DM) + lane;
#pragma unroll
            for (int j = 0; j < 4; ++j) v[r][j] = xr[64 * j]; }
        __builtin_amdgcn_sched_barrier(0);
#pragma unroll
        for (int r = 0; r < 4; ++r) { const int m = m0 + r * NGW; float s = 0.f;
#pragma unroll
            for (int j = 0; j < 4; ++j) s += (v[r][j].x * v[r][j].x + v[r][j].y * v[r][j].y) + (v[r][j].z * v[r][j].z + v[r][j].w * v[r][j].w);
            const float rr = rsqrtf(wave_sum(s) * (1.f / DM) + EPS);
            if (m < TC) { u32x2* o = (u32x2*)(xb + (size_t)m * DM) + lane;
#pragma unroll
                for (int j = 0; j < 4; ++j) o[64 * j] = (u32x2){cvt_pk_bf16(v[r][j].x * rr, v[r][j].y * rr), cvt_pk_bf16(v[r][j].z * rr, v[r][j].w * rr)}; } }
    }
}
__device__ __forceinline__ void rescale_rows(const bf16_t* raw, bf16_t* xb, const float* ssx, int gw, int NGW, int lane) {
    for (int m0 = gw; m0 < TC; m0 += 4 * NGW) {
        u32x4 w[4][2]; float t[4];
#pragma unroll
        for (int r = 0; r < 4; ++r) { const int m = m0 + r * NGW, mc = m < TC ? m : gw; t[r] = lane < 16 ? ssx[(size_t)mc * 16 + lane] : 0.f;
            const u32x4* o = (const u32x4*)(raw + (size_t)mc * LDP) + lane; w[r][0] = o[0]; w[r][1] = o[64]; }
        __builtin_amdgcn_sched_barrier(0);
#pragma unroll
        for (int r = 0; r < 4; ++r) { const int m = m0 + r * NGW; const float rr = rsqrtf(wave_sum(t[r]) * (1.f / DM) + EPS);
            if (m < TC) { u32x4* o = (u32x4*)(xb + (size_t)m * DM) + lane;
#pragma unroll
                for (int j = 0; j < 2; ++j) { u32x4 y;
#pragma unroll
                    for (int e = 0; e < 4; ++e) y[e] = cvt_pk_bf16(bf_lo(w[r][j][e]) * rr, bf_hi(w[r][j][e]) * rr);
                    o[64 * j] = y; } } }
    }
}

__global__ void __launch_bounds__(512) mega(Params P) {
    extern __shared__ __attribute__((aligned(16))) unsigned char lds_raw[];
    LAS unsigned char* lds = (LAS unsigned char*)lds_raw;
    cg::grid_group grid = cg::this_grid();
    const int G = gridDim.x;
    unsigned char* ws = P.ws;
    float* ropet = (float*)(ws + OFF_ROPE);
    float* lsebuf = (float*)(ws + OFF_LSE);
    float* SS = (float*)(ws + OFF_SS); float* SSX = (float*)(ws + OFF_SSX);
    bf16_t* QB = (bf16_t*)(ws + OFF_QB); bf16_t* KB = (bf16_t*)(ws + OFF_KB); bf16_t* VB = (bf16_t*)(ws + OFF_VB);
    bf16_t* XB = (bf16_t*)(ws + OFF_XB); bf16_t* PROJ = (bf16_t*)(ws + OFF_PROJ);
    volatile LAS unsigned* bst = (volatile LAS unsigned*)(lds + 147456 - 16);
    if (threadIdx.x < 4) bst[threadIdx.x] = 0u;
    __syncthreads();
    const XcdBarrier xbar = xcd_barrier_post((unsigned*)(ws + OFF_BAR), bst);
    for (int ph = P.ph_lo; ph < P.ph_hi; ++ph) {
        if (ph > P.ph_lo) { for (int rs_ = 0; rs_ < REP_SYNC; ++rs_) { if (P.ph_hi > 100000) grid.sync(); else xcd_barrier(xbar); } }
        int tid = threadIdx.x; asm volatile("" : "+v"(tid));
        int bx = blockIdx.x; asm volatile("" : "+s"(bx));
        const int lane = tid & 63, wave = __builtin_amdgcn_readfirstlane(tid >> 6);
        const int gw = bx * 8 + wave, NGW = G * 8;
        if (ph == 0) {
            for (int rp_ = 0; rp_ < REP_PRO; ++rp_) {
            LAS float* scr = (LAS float*)(lds + wave * 16384);
            constexpr int IT_IN = (LDP / 32) * 16, IT_UQ = 24 * 4, IT_UKV = 32 * 2, IT_OUT = 32 * 8, IT_O = 32 * 16, IT_L = IT_IN + IT_UQ + IT_UKV + 3 * IT_OUT + IT_O;
            for (int it = gw; it < 2 * IT_L; it += NGW) {
                const int l = it / IT_L; int r = it % IT_L; unsigned char* wl = ws + (size_t)l * W_LAYER;
                if (r < IT_IN) { const int rg = r >> 4, kb = r & 15; const int p0 = 32 * rg, pn = p0 >> 8, within = p0 & 255, bj = within >> 7, wc = (within >> 5) & 3;
                    const int L = 256 * pn + 64 * wc + 32 * bj; const int src = L < 2464 ? L : (L < 2560 ? -1 : L - 96);
                    if (pn < 8) transpose_item(P.in[I_WIN] + (size_t)l * 1024 * 11168, 11168, 1024, 64 * pn + 16 * wc, (bf16_t*)(wl + W_IN), p0, 64 * kb, scr, lane, P.in[I_NORMG] + l * DM, 2 * bj);
                    else transpose_item(P.in[I_WIN] + (size_t)l * 1024 * 11168, 11168, 1024, src, (bf16_t*)(wl + W_IN), p0, 64 * kb, scr, lane, P.in[I_NORMG] + l * DM);
                    continue; }
                r -= IT_IN;
                if (r < IT_UQ) { transpose_item(P.in[I_WUQ] + (size_t)l * 256 * 768, 768, 256, 32 * (r >> 2), (bf16_t*)(wl + W_UQ), 32 * (r >> 2), 64 * (r & 3), scr, lane, P.in[I_QAG] + l * 256); continue; }
                r -= IT_UQ;
                if (r < IT_UKV) { const int rg = r >> 1, p0 = 32 * rg, pn = p0 >> 8, within = p0 & 255, bj = within >> 7, wc = (within >> 5) & 3, wu = 4 * pn + wc;
                    const int src = (wu < 8 ? 128 * wu : 128 * (wu - 8) + 64) + 32 * bj;
                    transpose_item(P.in[I_WUKV] + (size_t)l * 128 * 1024, 1024, 128, src, (bf16_t*)(wl + W_UKV), p0, 64 * (r & 1), scr, lane, P.in[I_KVAG] + l * 128); continue; }
                r -= IT_UKV;
                if (r < 3 * IT_OUT) { const int br = r / IT_OUT, q = r % IT_OUT; const float* src = P.in[I_WOA + br] + (size_t)l * 512 * 1024;
                    transpose_item(src, 1024, 512, 32 * (q >> 3), (bf16_t*)(wl + W_OA + (size_t)br * 1024 * 512 * 2), 32 * (q >> 3), 64 * (q & 7), scr, lane); continue; }
                r -= 3 * IT_OUT;
                transpose_item(P.in[I_WO] + (size_t)l * 1024 * 1024, 1024, 1024, 32 * (r >> 4), (bf16_t*)(wl + W_O), 32 * (r >> 4), 64 * (r & 15), scr, lane);
            }
            for (int i = bx * 512 + tid; i < 2048 * 16; i += G * 512) {
                const int pos = i >> 4, f = i & 15;
                const float inv = exp2f(-(float)f * (13.287712379549449f / 16.f));
                const float ang = (float)pos * inv;
                const double rev = (double)ang * 0.15915494309189535; const double fr = rev - rint(rev);
                const float a = (float)(fr * 6.283185307179586);
                ropet[2 * i] = cosf(a); ropet[2 * i + 1] = sinf(a);
            }
            convert_rows(P.in[I_X], XB, gw, NGW, lane);
            }
            continue;
        }
        const int id = ph - 1, kk13 = id % 11, chunk = id / 11, layer = kk13 >= 5 ? 1 : 0, k = layer == 0 ? kk13 : kk13 - 6;
        const size_t tok0 = (size_t)chunk * TC;
        const float* xin = (layer == 0 ? P.in[I_X] : P.out) + tok0 * DM;
        float* xout = P.out + tok0 * DM;
        unsigned char* wl = ws + (size_t)layer * W_LAYER;
        if (k < 0) {
            rescale_rows(PROJ + C_XRAW, XB, SSX, gw, NGW, lane);
        } else if (k == 0) {
            pg8::Gemm g{XB, (const bf16_t*)(wl + W_IN), TC, LDP, DM, DM, DM}; pg8::StaticOrder S; S.init(TC, LDP, G, bx);
            for (int rp_ = 0; rp_ < REP_P1; ++rp_) { pg8::EpiProj E{PROJ, P.in[I_DQG] + layer * 192, P.in[I_DKG] + layer * 192, SS, P1_NOSTORE ? rp_ == REP_P1 - 1 : true, P.in[I_BGATE] + layer * 3072}; pg8::gemm_phase<pg8::EpiProj, pg8::StaticOrder>(lds, g, S, E, tid); asm volatile("" : "+v"(tid)); }
        } else if (k == 1) {
            for (int rp_ = 0; rp_ < REP_P2; ++rp_) {
            { int kk = 128; asm volatile("" : "+s"(kk)); pg8::Gemm g{PROJ + C_CKV, (const bf16_t*)(wl + W_UKV), TC, 1024, kk, LDP, 128}; pg8::StaticOrder S; S.init(TC, 1024, G, bx);
              pg8::EpiKV E{KB, VB, PROJ, SS, P.in[I_MKG] + layer * 96, ropet}; pg8::gemm_phase<pg8::EpiKV, pg8::StaticOrder>(lds, g, S, E, tid); }
            asm volatile("" : "+v"(tid)); asm volatile("" : "+s"(bx));
            { int kq = 256; asm volatile("" : "+s"(kq)); pg8::Gemm g{PROJ + C_CQ, (const bf16_t*)(wl + W_UQ), TC, 768, kq, LDP, 256}; pg8::StaticOrder S; S.init(TC, 768, G, G - 1 - bx);
              pg8::EpiPlain E{QB, 768}; pg8::gemm_phase<pg8::EpiPlain, pg8::StaticOrder>(lds, g, S, E, tid); }
            asm volatile("" : "+v"(tid)); }
            asm volatile("" : "+v"(tid)); asm volatile("" : "+s"(bx));
            const int hf = wave >> 2;
            for (int v = ((G & 7) == 0 ? (bx & 7) * (G >> 3) + (bx >> 3) : bx); v < 1536; v += G) {
                const int pp = v & 7, h = (v >> 3) & 7, gi = (v >> 6) % 3, b = v / 192;
                const int dil = gi == 0 ? 1 : (gi == 1 ? 4 : 16), nbc = 16 / dil;
                const int idx = 2 * pp + hf, r = idx / nbc, n = idx % nbc, n_other = (idx ^ 1) % nbc;
                const size_t row0 = (size_t)b * SEQ + r;
                HalfWork W;
                W.Q = PROJ + row0 * LDP + C_DQ + gi * 512 + 64 * h; W.K = PROJ + row0 * LDP + C_DK + gi * 512 + 64 * h; W.V = PROJ + row0 * LDP + C_DV + gi * 512 + 64 * h;
                W.O = const_cast<bf16_t*>(W.Q); W.lse = lsebuf + row0 * 24 + gi * 8 + h;
                W.rsq = W.rsk = W.rsv = W.rso = dil * LDP; W.rsl = dil * 24;
                const float slope = exp2f(-8.f * (float)(gi * 8 + h + 1) / 24.f);
                W.slope2 = slope * (float)dil * LOG2E; W.nback = 128;
                W.ssq = nullptr; W.gqn = nullptr; W.rope = nullptr;
                W.q0A = 128 * n; W.tloA = n > 0 ? 2 * n - 2 : 0; W.nA = 2 * n + 2 - W.tloA; W.q0B = 0; W.tloB = 0; W.nB = 0;
                const int n_oth = n_other > 0 ? 4 : 2;
                for (int rp_ = 0; rp_ < REP_DIL; ++rp_) attn_core<64, false>(lds, W, W.nA > n_oth ? W.nA : n_oth, tid, rp_ == REP_DIL - 1);
            }
            {
                const float* cw = P.in[I_CONVW] + layer * 3 * 512; const float* cb = P.in[I_CONVB] + layer * 512;
                for (int rp_ = 0; rp_ < REP_CONV; ++rp_)
                for (int it = bx * 512 + tid; it < (TC / 8) * 64; it += G * 512) {
                    const int cgp = it & 63, t0 = (it >> 6) * 8, c0 = 8 * cgp;
                    float w0[8], w1[8], w2[8], bb[8], u1[8], u2[8];
#pragma unroll
                    for (int e = 0; e < 8; ++e) { w0[e] = cw[c0 + e]; w1[e] = cw[512 + c0 + e]; w2[e] = cw[1024 + c0 + e]; bb[e] = cb[c0 + e]; u1[e] = 0.f; u2[e] = 0.f; }
                    if ((t0 & (SEQ - 1)) != 0) {
                        const u32x4 x1 = *(const u32x4*)(PROJ + (size_t)(t0 - 1) * LDP + C_AC + c0), x2 = *(const u32x4*)(PROJ + (size_t)(t0 - 2) * LDP + C_AC + c0);
#pragma unroll
                        for (int e = 0; e < 4; ++e) { u1[2 * e] = bf_lo(x1[e]); u1[2 * e + 1] = bf_hi(x1[e]); u2[2 * e] = bf_lo(x2[e]); u2[2 * e + 1] = bf_hi(x2[e]); }
                    }
                    u32x4 vg[8], vu[8];
#pragma unroll
                    for (int tt = 0; tt < 8; ++tt) { const bf16_t* rr = PROJ + (size_t)(t0 + tt) * LDP + c0; vg[tt] = *(const u32x4*)(rr + C_AB); vu[tt] = *(const u32x4*)(rr + C_AC); }
                    __builtin_amdgcn_sched_barrier(0);
#pragma unroll
                    for (int tt = 0; tt < 8; ++tt) {
                        bf16_t* rr = PROJ + (size_t)(t0 + tt) * LDP + c0; u32x4 y;
#pragma unroll
                        for (int e = 0; e < 4; ++e) {
                            const float ua = bf_lo(vu[tt][e]), ub = bf_hi(vu[tt][e]);
                            const float ca = bb[2 * e] + w0[2 * e] * u2[2 * e] + w1[2 * e] * u1[2 * e] + w2[2 * e] * ua;
                            const float cbv = bb[2 * e + 1] + w0[2 * e + 1] * u2[2 * e + 1] + w1[2 * e + 1] * u1[2 * e + 1] + w2[2 * e + 1] * ub;
                            u2[2 * e] = u1[2 * e]; u1[2 * e] = ua; u2[2 * e + 1] = u1[2 * e + 1]; u1[2 * e + 1] = ub;
                            y[e] = cvt_pk_bf16(bf_lo(vg[tt][e]) * ca, bf_hi(vg[tt][e]) * cbv); }
                        if (rp_ == REP_CONV - 1) *(u32x4*)(rr + C_AB) = y; else asm volatile("" :: "v"(y));
                    }
                }
            }
        } else if (k == 2) {
            const int hf = wave >> 2;
            for (int u = ((G & 7) == 0 ? (bx & 7) * (G >> 3) + (bx >> 3) : bx); u < 256; u += G) {
                const int b = u >> 5, hp = (u >> 3) & 3, p = u & 7, h = 2 * hp + hf;
                const int qbA = hf == 0 ? p : 15 - p, qbB = 15 - qbA;
                HalfWork W;
                W.Q = QB + (size_t)b * SEQ * 768 + 96 * h; W.K = KB + (size_t)b * SEQ * 768 + 96 * h; W.V = VB + (size_t)b * SEQ * 512 + 64 * h;
                W.O = PROJ + (size_t)b * SEQ * LDP + C_BZ + 64 * h; W.lse = nullptr;
                W.rsq = 768; W.rsk = 768; W.rsv = 512; W.rso = LDP; W.rsl = 0; W.slope2 = 0.f; W.nback = 1 << 28;
                W.ssq = SS + (size_t)b * SEQ * 8; W.gqn = P.in[I_MQG] + layer * 96; W.rope = ropet;
                W.q0A = 128 * qbA; W.tloA = 0; W.nA = 2 * qbA + 2; W.q0B = 128 * qbB; W.tloB = 0; W.nB = 2 * qbB + 2;
                for (int rp_ = 0; rp_ < REP_MLA; ++rp_) attn_core<96, true>(lds, W, 34, tid, rp_ == REP_MLA - 1);
            }
            for (int rp_ = 0; rp_ < REP_E3; ++rp_)
            for (int m0 = gw; m0 < TC; m0 += 4 * NGW) {
                const int h = lane >> 3, dc = lane & 7;
                u32x4 oa[4], ob[4], oc[4], zz[4]; float la[4], lb[4], lc[4];
#pragma unroll
                for (int r = 0; r < 4; ++r) { const int m = m0 + r * NGW, mc = m < TC ? m : gw; const bf16_t* row = PROJ + (size_t)mc * LDP; const float* ls = lsebuf + (size_t)mc * 24 + h;
                    la[r] = ls[0]; lb[r] = ls[8]; lc[r] = ls[16];
                    oa[r] = *(const u32x4*)(row + C_DQ + 64 * h + 8 * dc); ob[r] = *(const u32x4*)(row + C_DQ + 512 + 64 * h + 8 * dc); oc[r] = *(const u32x4*)(row + C_DQ + 1024 + 64 * h + 8 * dc);
                    zz[r] = *(const u32x4*)(row + C_CZ + 64 * h + 8 * dc); }
                __builtin_amdgcn_sched_barrier(0);
#pragma unroll
                for (int r = 0; r < 4; ++r) { const int m = m0 + r * NGW;
                    const float mx = fmaxf(la[r], fmaxf(lb[r], lc[r]));
                    float a0 = __builtin_amdgcn_exp2f(la[r] - mx), a1 = __builtin_amdgcn_exp2f(lb[r] - mx), a2 = __builtin_amdgcn_exp2f(lc[r] - mx); const float inv = __builtin_amdgcn_rcpf(a0 + a1 + a2); a0 *= inv; a1 *= inv; a2 *= inv;
                    u32x4 y;
#pragma unroll
                    for (int e = 0; e < 4; ++e) {
                        const float lo = (a0 * bf_lo(oa[r][e]) + a1 * bf_lo(ob[r][e]) + a2 * bf_lo(oc[r][e])) * silu_f(bf_lo(zz[r][e]));
                        const float hi = (a0 * bf_hi(oa[r][e]) + a1 * bf_hi(ob[r][e]) + a2 * bf_hi(oc[r][e])) * silu_f(bf_hi(zz[r][e]));
                        y[e] = cvt_pk_bf16(lo, hi); }
                    if (m < TC) { if (rp_ == REP_E3 - 1) *(u32x4*)(PROJ + (size_t)m * LDP + C_CZ + 64 * h + 8 * dc) = y; else asm volatile("" :: "v"(y)); } }
            }
        } else if (k == 3) {
            pg8::MergeOrder S; S.base.init(TC, DM, G, bx);
            for (int rp_ = 0; rp_ < REP_P4; ++rp_) {
            pg8::Gemm g{PROJ, (const bf16_t*)(wl + W_OA), TC, DM, 512, LDP, 512}; pg8::EpiMerge E{PROJ, P.in[I_BGATE] + layer * 3072};
            pg8::gemm_phase<pg8::EpiMerge, pg8::MergeOrder>(lds, g, S, E, tid); asm volatile("" : "+v"(tid)); }
        } else {
            pg8::Gemm g{PROJ + C_MB, (const bf16_t*)(wl + W_O), TC, DM, DM, LDP, DM}; pg8::StaticOrder S; S.init(TC, DM, G, bx);
            if (layer == 0) { pg8::EpiRes<false> E{xin, nullptr, nullptr, PROJ + C_XRAW, SSX}; pg8::gemm_phase<pg8::EpiRes<false>, pg8::StaticOrder>(lds, g, S, E, tid); }
            else { pg8::EpiRes<true> E{nullptr, PROJ + C_XRAW, xout, nullptr, nullptr}; pg8::gemm_phase<pg8::EpiRes<true>, pg8::StaticOrder>(lds, g, S, E, tid); }
            asm volatile("" : "+v"(tid));
            if (layer == 1 && chunk + 1 < NCH) convert_rows(P.in[I_X] + (tok0 + TC) * DM, XB, gw, NGW, lane);
        }
    }
}

constexpr int N_PHASES = 1 + NCH * 11;
constexpr int LDS_BYTES = 147456;

extern "C" void kernel_launch(void* const* d_in, const int* in_sizes, int n_in, void* d_out, int out_size, void* d_ws, size_t ws_size, hipStream_t stream) {
    static int grid = 0;
    if (grid == 0) {
        int dev = 0, cus = 0, per_cu = 0;
        hipGetDevice(&dev);
        hipDeviceGetAttribute(&cus, hipDeviceAttributeMultiprocessorCount, dev);
        hipFuncSetAttribute((const void*)mega, hipFuncAttributeMaxDynamicSharedMemorySize, LDS_BYTES);
        hipOccupancyMaxActiveBlocksPerMultiprocessor(&per_cu, (const void*)mega, 512, LDS_BYTES);
        (void)hipGetLastError();
        grid = cus;
        if (n_in != 18 || ws_size < WS_END || out_size != NB * SEQ * DM) { fprintf(stderr, "kernel_launch: unexpected shapes / workspace\n"); grid = -1; }
    }
    if (grid < 0) return;
    (void)hipMemsetAsync((unsigned char*)d_ws + OFF_BAR, 0, 16384, stream);
    Params p{};
    for (int i = 0; i < 18; ++i) p.in[i] = (const float*)d_in[i];
    p.out = (float*)d_out; p.ws = (unsigned char*)d_ws; p.ph_lo = 0; p.ph_hi = N_PHASES;
    void* args[] = {&p};
    hipError_t e = hipLaunchCooperativeKernel((const void*)mega, dim3(grid), dim3(512), args, LDS_BYTES, stream);
    if (e != hipSuccess) fprintf(stderr, "cooperative launch failed: %s\n", hipGetErrorString(e));
}
```
